# Optimizing an MI355X kernel written in HIP

```python
import jax, jax.numpy as jnp
from jax import lax
import numpy as np

D_MODEL = 1024
BATCH = 16
SEQ = 2048
DEPTH = 1

MEM_LEN = 256
MIX_WIDTH = D_MODEL
FOX_HEADS = 8
FOX_HEAD_DIM = (MIX_WIDTH // 2) // FOX_HEADS
FOX_WIDTH = FOX_HEADS * FOX_HEAD_DIM
GDN_HEADS = 4
GDN_HEAD_DIM = (MIX_WIDTH // 2) // GDN_HEADS
GDN_WIDTH = GDN_HEADS * GDN_HEAD_DIM
CONV_WIDTH = 4
GDN_CHUNK = 64
Q_BLOCK = 128
XATTN_HEADS = 4
XATTN_HEAD_DIM = 128
XATTN_WIDTH = XATTN_HEADS * XATTN_HEAD_DIM
D_FF = 4 * D_MODEL
EPS = 1e-6
NEG_INF = -1e30

IN_SIZES = [3 * FOX_WIDTH, FOX_HEADS, 3 * GDN_WIDTH, GDN_HEADS, GDN_HEADS, GDN_WIDTH]
IN_DIM = sum(IN_SIZES)
IN_OFFSETS = [int(o) for o in np.cumsum(IN_SIZES)[:-1]]

kernel_name = "hymba_fox_gdn_memxattn_block"


def rms_norm(x, g):
    xf = x.astype(jnp.float32)
    y = xf * lax.rsqrt(jnp.mean(xf * xf, axis=-1, keepdims=True) + EPS)
    return (y * g.astype(jnp.float32)).astype(x.dtype)


def l2_norm(x):
    xf = x.astype(jnp.float32)
    return (xf * lax.rsqrt(jnp.sum(xf * xf, axis=-1, keepdims=True) + EPS)).astype(x.dtype)


def causal_depthwise_conv(x, w):
    C = x.shape[-1]
    return lax.conv_general_dilated(
        x, w[:, None, :].astype(x.dtype), window_strides=(1,),
        padding=((CONV_WIDTH - 1, 0),),
        dimension_numbers=("NWC", "WIO", "NWC"),
        feature_group_count=C)


def forgetting_attention(q, k, v, f_logit):
    B, S, H, Dh = q.shape
    nb = S // Q_BLOCK
    scale = Dh ** -0.5
    c = jnp.cumsum(jax.nn.log_sigmoid(f_logit.astype(jnp.float32)), axis=1)
    c = c.transpose(0, 2, 1)
    q_blocks = q.reshape(B, nb, Q_BLOCK, H, Dh).transpose(1, 0, 3, 2, 4)
    c_blocks = c.reshape(B, H, nb, Q_BLOCK).transpose(2, 0, 1, 3)
    kpos = jnp.arange(S)

    def block(args):
        i, q_i, c_i = args
        qpos = i * Q_BLOCK + jnp.arange(Q_BLOCK)
        s = jnp.einsum("bhqd,bshd->bhqs", q_i, k,
                       preferred_element_type=jnp.float32) * scale
        s = s + c_i[..., :, None] - c[:, :, None, :]
        s = jnp.where(kpos[None, :] <= qpos[:, None], s, NEG_INF)
        p = jax.nn.softmax(s, axis=-1)
        return jnp.einsum("bhqs,bshd->bqhd", p.astype(v.dtype), v)

    out = lax.map(block, (jnp.arange(nb), q_blocks, c_blocks))
    return out.transpose(1, 0, 2, 3, 4).reshape(B, S, H, Dh)


def gated_delta_rule(q, k, v, g, beta):
    out_dtype = v.dtype
    B, S, H, Dk = q.shape
    Dv = v.shape[-1]
    C = GDN_CHUNK
    N = S // C
    f32 = jnp.float32

    def chunk(t):
        t = t.astype(f32).reshape((B, N, C, H) + t.shape[3:])
        return jnp.moveaxis(t, 3, 1)

    q = chunk(q) * (Dk ** -0.5)
    k = chunk(k)
    v = chunk(v)
    beta = chunk(beta)
    gc = jnp.cumsum(chunk(g), axis=-1)

    idx = jnp.arange(C)
    lower_incl = idx[:, None] >= idx[None, :]
    strict = idx[:, None] > idx[None, :]
    decay = jnp.exp(jnp.where(lower_incl, gc[..., :, None] - gc[..., None, :], NEG_INF))

    k_beta = k * beta[..., None]
    v_beta = v * beta[..., None]
    L = jnp.where(strict, jnp.einsum("bhncd,bhnsd->bhncs", k_beta, k) * decay, 0.0)
    eye = jnp.broadcast_to(jnp.eye(C, dtype=f32), L.shape)
    T = lax.linalg.triangular_solve(eye + L, eye, left_side=True, lower=True)
    u = jnp.einsum("bhncs,bhnse->bhnce", T, v_beta)
    w = jnp.einsum("bhncs,bhnsd->bhncd", T, k_beta * jnp.exp(gc)[..., None])
    intra = jnp.einsum("bhncd,bhnsd->bhncs", q, k) * decay

    def to_scan(t):
        return jnp.moveaxis(t, 2, 0)

    def step(state, xs):
        q_n, k_n, u_n, w_n, gc_n, intra_n = xs
        v_new = u_n - jnp.einsum("bhcd,bhde->bhce", w_n, state)
        o = (jnp.einsum("bhcd,bhde->bhce", q_n * jnp.exp(gc_n)[..., None], state)
             + jnp.einsum("bhcs,bhse->bhce", intra_n, v_new))
        g_last = gc_n[..., -1]
        state = (state * jnp.exp(g_last)[..., None, None]
                 + jnp.einsum("bhcd,bhce->bhde",
                              k_n * jnp.exp(g_last[..., None] - gc_n)[..., None], v_new))
        return state, o

    state0 = jnp.zeros((B, H, Dk, Dv), f32)
    _, o = lax.scan(step, state0, (to_scan(q), to_scan(k), to_scan(u), to_scan(w),
                                   to_scan(gc), to_scan(intra)))
    return o.transpose(1, 0, 3, 2, 4).reshape(B, S, H, Dv).astype(out_dtype)


def setup_inputs(seed: int = 0) -> dict:
    key = jax.random.key(seed)
    ks = jax.random.split(key, 26)
    L = DEPTH
    f32 = jnp.float32

    def nrm(k, shape, scale):
        return jax.random.normal(k, shape, f32) * scale

    def gain(k, dim):
        return 1.0 + 0.02 * jax.random.normal(k, (L, dim), f32)

    dt = jnp.exp(jax.random.uniform(ks[10], (L, GDN_HEADS), f32,
                                    minval=np.log(0.001), maxval=np.log(0.1)))
    return {
        "x": nrm(ks[0], (BATCH, SEQ, D_MODEL), 1.0),
        "mem": nrm(ks[1], (BATCH, MEM_LEN, D_MODEL), 1.0),
        "norm_mix_g": gain(ks[2], D_MODEL),
        "w_in": nrm(ks[3], (L, D_MODEL, IN_DIM), D_MODEL ** -0.5),
        "fox_qnorm_g": gain(ks[4], FOX_HEAD_DIM),
        "fox_knorm_g": gain(ks[5], FOX_HEAD_DIM),
        "fox_f_bias": 2.0 + 0.5 * jax.random.normal(ks[6], (L, FOX_HEADS), f32),
        "fox_onorm_g": gain(ks[7], FOX_HEAD_DIM),
        "gdn_conv_w": nrm(ks[8], (L, CONV_WIDTH, 3 * GDN_WIDTH), CONV_WIDTH ** -0.5),
        "gdn_A_log": jnp.log(jax.random.uniform(ks[9], (L, GDN_HEADS), f32, minval=1.0, maxval=16.0)),
        "gdn_dt_bias": dt + jnp.log(-jnp.expm1(-dt)),
        "gdn_onorm_g": gain(ks[11], GDN_HEAD_DIM),
        "w_out": nrm(ks[12], (L, MIX_WIDTH, D_MODEL), MIX_WIDTH ** -0.5),
        "norm_xattn_g": gain(ks[13], D_MODEL),
        "mem_norm_g": gain(ks[14], D_MODEL),
        "w_cq": nrm(ks[15], (L, D_MODEL, XATTN_WIDTH), D_MODEL ** -0.5),
        "w_ckv": nrm(ks[16], (L, D_MODEL, 2 * XATTN_WIDTH), D_MODEL ** -0.5),
        "xattn_qnorm_g": gain(ks[17], XATTN_HEAD_DIM),
        "xattn_knorm_g": gain(ks[18], XATTN_HEAD_DIM),
        "w_co": nrm(ks[19], (L, XATTN_WIDTH, D_MODEL), XATTN_WIDTH ** -0.5),
        "norm_mlp_g": gain(ks[20], D_MODEL),
        "w_mlp1": nrm(ks[21], (L, D_MODEL, D_FF), D_MODEL ** -0.5),
        "w_mlp2": nrm(ks[22], (L, D_FF, D_MODEL), D_FF ** -0.5),
    }


def reference(x, mem, norm_mix_g, w_in, fox_qnorm_g, fox_knorm_g, fox_f_bias, fox_onorm_g,
              gdn_conv_w, gdn_A_log, gdn_dt_bias, gdn_onorm_g, w_out,
              norm_xattn_g, mem_norm_g, w_cq, w_ckv, xattn_qnorm_g, xattn_knorm_g, w_co,
              norm_mlp_g, w_mlp1, w_mlp2):
    B, S, _ = x.shape
    M = mem.shape[1]
    for l in range(DEPTH):
        h = rms_norm(x, norm_mix_g[l])
        proj = h @ w_in[l]
        fox_qkv, fox_f, gdn_qkv, gdn_b, gdn_a, gdn_z = jnp.split(proj, IN_OFFSETS, axis=-1)

        fq, fk, fv = jnp.split(fox_qkv.reshape(B, S, 3 * FOX_HEADS, FOX_HEAD_DIM), 3, axis=2)
        fq = rms_norm(fq, fox_qnorm_g[l])
        fk = rms_norm(fk, fox_knorm_g[l])
        o_a = forgetting_attention(fq, fk, fv, fox_f + fox_f_bias[l])
        o_a = rms_norm(o_a, fox_onorm_g[l]).reshape(B, S, FOX_WIDTH)

        gqkv = jax.nn.silu(causal_depthwise_conv(gdn_qkv, gdn_conv_w[l]))
        gq, gk, gv = jnp.split(gqkv.reshape(B, S, 3 * GDN_HEADS, GDN_HEAD_DIM), 3, axis=2)
        gq = l2_norm(gq)
        gk = l2_norm(gk)
        beta = jax.nn.sigmoid(gdn_b.astype(jnp.float32))
        g = -jnp.exp(gdn_A_log[l].astype(jnp.float32)) * jax.nn.softplus(
            (gdn_a + gdn_dt_bias[l]).astype(jnp.float32))
        o_b = gated_delta_rule(gq, gk, gv, g, beta)
        o_b = rms_norm(o_b, gdn_onorm_g[l]) * jax.nn.silu(gdn_z.reshape(B, S, GDN_HEADS, GDN_HEAD_DIM))
        o_b = o_b.reshape(B, S, GDN_WIDTH)

        x = x + jnp.concatenate([o_a, o_b], axis=-1) @ w_out[l]

        hq = rms_norm(x, norm_xattn_g[l])
        hm = rms_norm(mem, mem_norm_g[l])
        cq = rms_norm((hq @ w_cq[l]).reshape(B, S, XATTN_HEADS, XATTN_HEAD_DIM), xattn_qnorm_g[l])
        ck, cv = jnp.split((hm @ w_ckv[l]).reshape(B, M, 2 * XATTN_HEADS, XATTN_HEAD_DIM), 2, axis=2)
        ck = rms_norm(ck, xattn_knorm_g[l])
        s = jnp.einsum("bqhd,bmhd->bhqm", cq, ck,
                       preferred_element_type=jnp.float32) * (XATTN_HEAD_DIM ** -0.5)
        p = jax.nn.softmax(s, axis=-1)
        co = jnp.einsum("bhqm,bmhd->bqhd", p.astype(cv.dtype), cv).reshape(B, S, XATTN_WIDTH)
        x = x + co @ w_co[l]

        hf = rms_norm(x, norm_mlp_g[l])
        x = x + jnp.square(jax.nn.relu(hf @ w_mlp1[l])) @ w_mlp2[l]
    return x
```

```cpp
#include <hip/hip_runtime.h>
#include <hip/hip_cooperative_groups.h>
#include <cstdio>
#include <cstdint>
namespace cg = cooperative_groups;
#ifndef MK_MULTI
#define MK_MULTI 0
#endif
namespace pg8 {
#define PG8_LAS __attribute__((address_space(3)))
typedef unsigned short bf16_t;
typedef short bf16x8 __attribute__((ext_vector_type(8)));
typedef float f32x4 __attribute__((ext_vector_type(4)));
typedef unsigned u32x4 __attribute__((ext_vector_type(4)));
constexpr int BM = 256, BK = 64, HALF = 128, HTB = HALF * BK * 2  , STAGE_BYTES = 8 * HTB, NXCD = 8, WGM = 8;

__host__ __device__ __forceinline__ int lds_byte(int r, int c) { const int st = (r >> 4) * 2 + (c >> 5), rr = r & 15, cc = c & 31, ob = rr * 64 + cc * 2; return st * 1024 + (ob ^ (((ob >> 9) & 1) << 5)); }
__host__ __device__ __forceinline__ void stage_rc(int b, int& R, int& C) { const int st = b / 1024, sb = b % 1024, swz = sb ^ (((sb >> 9) & 1) << 5); R = (st >> 1) * 16 + swz / 64; C = (st & 1) * 32 + (swz % 64) / 2; }
__host__ __device__ __forceinline__ int perm32(int rho) { const int n = rho >> 4, i = rho & 15; return 8 * (i >> 2) + 4 * n + (i & 3); }

struct Unit { int pm, pn; };
struct Gemm { const bf16_t* A; const bf16_t* Bt; int M, N, K; };

struct StaticOrder {
    int nM, nN, nwg, G, c;
    __host__ __device__ void init(int M, int N, int G_, int c_) { nM = M / BM; nN = N / BM; nwg = nM * nN; G = G_; c = c_; }
    __host__ __device__ bool next(int i, Unit& u) const {
        const long L = (long)i * G + c; if (L >= nwg) return false;
        int wgid = (int)L; { const int q = nwg / NXCD, r = nwg % NXCD, xcd = wgid % NXCD, off = wgid / NXCD; wgid = (xcd < r ? xcd * (q + 1) : r * (q + 1) + (xcd - r) * q) + off; }
        const int nig = WGM * nN, gid = wgid / nig, fm = gid * WGM, gsz = (nM - fm) < WGM ? (nM - fm) : WGM;
        u.pm = fm + ((wgid % nig) % gsz); u.pn = (wgid % nig) / gsz; return true;
    }
    __device__ __forceinline__ void a_ready(const Unit&) const {}
    __device__ __forceinline__ void done(const Unit&) const {}
};
__device__ __forceinline__ unsigned cvt_pk_bf16(float lo, float hi) { unsigned r; asm volatile("v_cvt_pk_bf16_f32 %0, %1, %2" : "=v"(r) : "v"(lo), "v"(hi)); return r; }
template <int ACT, bool RS> struct EpiStore {
    static constexpr bool PERM = true, AFTER_DRAIN = false;
    bf16_t* O; int ldc; const float* ssq;
    __device__ __forceinline__ void operator()(const f32x4 (&acc)[2][2][4][2], const Unit& u, int wr, int wc, int fr, int fq) const {
        const int row0 = u.pm * BM + wr * 64 + fr, col0 = u.pn * BM + wc * 32 + 8 * fq;
#pragma unroll
        for (int ai = 0; ai < 2; ++ai)
#pragma unroll
            for (int m = 0; m < 4; ++m) {
                const int row = row0 + ai * HALF + m * 16;
                float rs = 1.f; if (RS) rs = rsqrtf(ssq[row] * (1.0f / 1024.0f) + 1e-6f);
                bf16_t* rowp = O + (size_t)row * ldc + col0;
#pragma unroll
                for (int bj = 0; bj < 2; ++bj) {
                    f32x4 v0 = acc[ai][bj][m][0] * rs, v1 = acc[ai][bj][m][1] * rs;
                    if (ACT == 2) {
#pragma unroll
                        for (int e = 0; e < 4; ++e) { float a = fmaxf(v0[e], 0.f), b = fmaxf(v1[e], 0.f); v0[e] = a * a; v1[e] = b * b; }
                    }
                    u32x4 w; w.x = cvt_pk_bf16(v0[0], v0[1]); w.y = cvt_pk_bf16(v0[2], v0[3]); w.z = cvt_pk_bf16(v1[0], v1[1]); w.w = cvt_pk_bf16(v1[2], v1[3]);
                    *(u32x4*)(rowp + bj * HALF) = w;
                }
            }
    }
};
struct EpiRes {
    static constexpr bool PERM = true, AFTER_DRAIN = false;
    const float* base; float* out; bf16_t* xb; float* ssq;
    __device__ __forceinline__ void operator()(const f32x4 (&acc)[2][2][4][2], const Unit& u, int wr, int wc, int fr, int fq) const {
        const int row0 = u.pm * BM + wr * 64 + fr, col0 = u.pn * BM + wc * 32 + 8 * fq;
#pragma unroll
        for (int ai = 0; ai < 2; ++ai)
#pragma unroll
            for (int m = 0; m < 4; ++m) {
                const int row = row0 + ai * HALF + m * 16; float s = 0.f;
#pragma unroll
                for (int bj = 0; bj < 2; ++bj) {
                    const size_t off = (size_t)row * 1024 + col0 + bj * HALF;
                    const f32x4 b0 = *(const f32x4*)(base + off), b1 = *(const f32x4*)(base + off + 4);
                    const f32x4 v0 = acc[ai][bj][m][0] + b0, v1 = acc[ai][bj][m][1] + b1;
                    *(f32x4*)(out + off) = v0; *(f32x4*)(out + off + 4) = v1;
                    if (xb) { u32x4 w; w.x = cvt_pk_bf16(v0[0], v0[1]); w.y = cvt_pk_bf16(v0[2], v0[3]); w.z = cvt_pk_bf16(v1[0], v1[1]); w.w = cvt_pk_bf16(v1[2], v1[3]); *(u32x4*)(xb + off) = w; }
                    s += (v0[0] * v0[0] + v0[1] * v0[1]) + (v0[2] * v0[2] + v0[3] * v0[3]) + (v1[0] * v1[0] + v1[1] * v1[1]) + (v1[2] * v1[2] + v1[3] * v1[3]);
                }
                if (ssq) { s += __shfl_xor(s, 16); s += __shfl_xor(s, 32); if (fq == 0) atomicAdd(ssq + row, s); }
            }
    }
};

template <class Epi, class Sched, bool ALIGN_EPI = false, bool SP2 = false>
__device__ __forceinline__ void gemm_phase(PG8_LAS unsigned char* lds, const Gemm g, const Sched& S, const Epi& E) {
    const int tid = threadIdx.x, wid = __builtin_amdgcn_readfirstlane(tid >> 6), lane = tid & 63, wr = wid >> 2, wc = wid & 3, fr = lane & 15, fq = lane >> 4;
    const int K = g.K, nt = K / BK;
    unsigned voffA[2], voffB[2];
#pragma unroll
    for (int i = 0; i < 2; ++i) { int R, C; stage_rc(tid * 16 + i * 8192, R, C); const int Rb = Epi::PERM ? ((R & ~31) + perm32(R & 31)) : R;
        voffA[i] = (unsigned)(R * K + C) * 2u; voffB[i] = (unsigned)(Rb * K + C) * 2u; }
    const size_t kstep = (size_t)(BK * 2);
    const size_t hstep = (size_t)HALF * K * 2;
    const size_t tstep = 2 * hstep;
    const unsigned ldsw = (unsigned)wid * 1024u;
    const int aoff = lds_byte(wr * 64 + fr, fq * 8), boff = lds_byte(wc * 32 + fr, fq * 8);
#define PG8_SA(b, h) (((b) * 2 + (h)) * HTB)
#define PG8_SB(b, h) ((4 + (b) * 2 + (h)) * HTB)
#define PG8_STAGE(bufoff, gbase, voff) do { _Pragma("unroll") for (int _i = 0; _i < 2; ++_i) \
        __builtin_amdgcn_global_load_lds((const unsigned*)((const char*)(gbase) + (voff)[_i]), (PG8_LAS unsigned*)(lds + (bufoff) + ldsw + _i * 8192), 16, 0, 0); } while (0)
#define PG8_LDA(dst, b, h) do { _Pragma("unroll") for (int m = 0; m < 4; ++m) _Pragma("unroll") for (int k = 0; k < 2; ++k) dst[m][k] = *(const PG8_LAS bf16x8*)(lds + PG8_SA(b, h) + aoff + m * 2048 + k * 1024); } while (0)
#define PG8_LDB(dst, b, h) do { _Pragma("unroll") for (int n = 0; n < 2; ++n) _Pragma("unroll") for (int k = 0; k < 2; ++k) dst[n][k] = *(const PG8_LAS bf16x8*)(lds + PG8_SB(b, h) + boff + n * 2048 + k * 1024); } while (0)
#define PG8_MMA(ai, bj, At, Bt) do { __builtin_amdgcn_s_setprio(1); _Pragma("unroll") for (int m = 0; m < 4; ++m) _Pragma("unroll") for (int n = 0; n < 2; ++n) _Pragma("unroll") for (int k = 0; k < 2; ++k) \
        acc[ai][bj][m][n] = __builtin_amdgcn_mfma_f32_16x16x32_bf16(Bt[n][k], At[m][k], acc[ai][bj][m][n], 0, 0, 0); __builtin_amdgcn_s_setprio(0); } while (0)
#define PG8_WAIT_V(n) asm volatile("s_waitcnt vmcnt(" #n ")" ::: "memory")
#define PG8_WAIT_L(n) asm volatile("s_waitcnt lgkmcnt(" #n ")" ::: "memory")
#define PG8_BAR __builtin_amdgcn_s_barrier()
#define PG8_SCHED __builtin_amdgcn_sched_barrier(0)
    Unit cur, nxt; int ui = 0;
    if (!S.next(0, cur)) return;
    f32x4 acc[2][2][4][2];
#pragma unroll
    for (int a = 0; a < 2; ++a)
#pragma unroll
        for (int b = 0; b < 2; ++b)
#pragma unroll
            for (int m = 0; m < 4; ++m)
#pragma unroll
                for (int n = 0; n < 2; ++n) acc[a][b][m][n] = (f32x4){0.f, 0.f, 0.f, 0.f};
    bf16x8 At[4][2], B0[2][2], B1[2][2];
    const char* cA = (const char*)g.A + (size_t)cur.pm * tstep; const char* cB = (const char*)g.Bt + (size_t)cur.pn * tstep;
    S.a_ready(cur);
    if constexpr (SP2) {
        PG8_STAGE(PG8_SB(0, 0), cB, voffB); PG8_STAGE(PG8_SB(0, 1), cB + hstep, voffB); PG8_STAGE(PG8_SA(0, 0), cA, voffA); PG8_STAGE(PG8_SA(0, 1), cA + hstep, voffA);
        if (wr == 1) PG8_BAR;
        PG8_WAIT_V(2); PG8_BAR;
        PG8_STAGE(PG8_SB(1, 0), cB + kstep, voffB); PG8_STAGE(PG8_SA(1, 0), cA + kstep, voffA); PG8_STAGE(PG8_SB(1, 1), cB + hstep + kstep, voffB);
        PG8_WAIT_V(6); PG8_BAR;
    } else {
        PG8_STAGE(PG8_SB(0, 0), cB, voffB); PG8_STAGE(PG8_SA(0, 0), cA, voffA); PG8_STAGE(PG8_SB(0, 1), cB + hstep, voffB); PG8_STAGE(PG8_SA(0, 1), cA + hstep, voffA);
        if (wr == 1) PG8_BAR;
        PG8_WAIT_V(4); PG8_BAR;
        PG8_STAGE(PG8_SB(1, 0), cB + kstep, voffB); PG8_STAGE(PG8_SA(1, 0), cA + kstep, voffA); PG8_STAGE(PG8_SB(1, 1), cB + hstep + kstep, voffB);
        PG8_WAIT_V(6); PG8_BAR;
    }
    for (;;) {
        const bool has_next = S.next(ui + 1, nxt);
        const char* nA = has_next ? (const char*)g.A + (size_t)nxt.pm * tstep : cA; const char* nB = has_next ? (const char*)g.Bt + (size_t)nxt.pn * tstep : cB;
        for (int t = 0; t < nt; t += 2) {
            const bool last = (t == nt - 2);
            const char* a1 = cA + (size_t)(t + 1) * kstep;
            const char* a2 = last ? nA : cA + (size_t)(t + 2) * kstep; const char* b2 = last ? nB : cB + (size_t)(t + 2) * kstep;
            const char* a3 = a2 + kstep; const char* b3 = b2 + kstep;
            if (last && has_next) S.a_ready(nxt);
            if constexpr (SP2) {
            PG8_LDB(B0, 0, 0); PG8_LDB(B1, 0, 1); PG8_SCHED; PG8_LDA(At, 0, 0); PG8_STAGE(PG8_SA(1, 1), a1 + hstep, voffA);
            PG8_WAIT_V(8); PG8_WAIT_L(0); PG8_BAR; PG8_MMA(0, 0, At, B0); PG8_MMA(0, 1, At, B1); PG8_BAR; PG8_SCHED;
            PG8_LDA(At, 0, 1); PG8_STAGE(PG8_SB(0, 0), b2, voffB); PG8_STAGE(PG8_SB(0, 1), b2 + hstep, voffB); PG8_STAGE(PG8_SA(0, 0), a2, voffA);
            PG8_WAIT_V(8); PG8_WAIT_L(0); PG8_BAR; PG8_MMA(1, 0, At, B0); PG8_MMA(1, 1, At, B1); PG8_BAR; PG8_SCHED;
            PG8_LDB(B0, 1, 0); PG8_LDB(B1, 1, 1); PG8_SCHED; PG8_LDA(At, 1, 0); PG8_STAGE(PG8_SA(0, 1), a2 + hstep, voffA);
            PG8_WAIT_V(8); PG8_WAIT_L(0); PG8_BAR; PG8_MMA(0, 0, At, B0); PG8_MMA(0, 1, At, B1); PG8_BAR; PG8_SCHED;
            PG8_LDA(At, 1, 1); PG8_STAGE(PG8_SB(1, 0), b3, voffB); PG8_STAGE(PG8_SB(1, 1), b3 + hstep, voffB); PG8_STAGE(PG8_SA(1, 0), a3, voffA);
            PG8_WAIT_V(8); PG8_WAIT_L(0); PG8_BAR; PG8_MMA(1, 0, At, B0); PG8_MMA(1, 1, At, B1); PG8_BAR; PG8_SCHED;
            } else {
            PG8_LDB(B0, 0, 0); PG8_SCHED; PG8_LDA(At, 0, 0); PG8_STAGE(PG8_SA(1, 1), a1 + hstep, voffA);
            PG8_WAIT_L(8); PG8_BAR; PG8_WAIT_L(0); PG8_MMA(0, 0, At, B0); PG8_BAR; PG8_SCHED;
            PG8_LDB(B1, 0, 1); PG8_STAGE(PG8_SB(0, 0), b2, voffB);
            PG8_BAR; PG8_WAIT_L(0); PG8_MMA(0, 1, At, B1); PG8_BAR;
            PG8_LDA(At, 0, 1); PG8_STAGE(PG8_SA(0, 0), a2, voffA);
            PG8_BAR; PG8_WAIT_L(0); PG8_MMA(1, 0, At, B0); PG8_BAR; PG8_SCHED;
            PG8_STAGE(PG8_SB(0, 1), b2 + hstep, voffB);
            PG8_WAIT_V(6); PG8_BAR; PG8_MMA(1, 1, At, B1); PG8_BAR;
            PG8_LDB(B0, 1, 0); PG8_SCHED; PG8_LDA(At, 1, 0); PG8_STAGE(PG8_SA(0, 1), a2 + hstep, voffA);
            PG8_WAIT_L(8); PG8_BAR; PG8_WAIT_L(0); PG8_MMA(0, 0, At, B0); PG8_BAR; PG8_SCHED;
            PG8_LDB(B1, 1, 1); PG8_STAGE(PG8_SB(1, 0), b3, voffB);
            PG8_BAR; PG8_WAIT_L(0); PG8_MMA(0, 1, At, B1); PG8_BAR;
            PG8_LDA(At, 1, 1); PG8_STAGE(PG8_SA(1, 0), a3, voffA);
            PG8_BAR; PG8_WAIT_L(0); PG8_MMA(1, 0, At, B0); PG8_BAR; PG8_SCHED;
            PG8_STAGE(PG8_SB(1, 1), b3 + hstep, voffB);
            PG8_WAIT_V(6); PG8_BAR; PG8_MMA(1, 1, At, B1); PG8_BAR;
            }
        }
        if constexpr (ALIGN_EPI) { if (wr == 0) PG8_BAR; }
        if constexpr (!Epi::AFTER_DRAIN) { E(acc, cur, wr, wc, fr, fq); S.done(cur); }
        if (!has_next) break;
#pragma unroll
        for (int a = 0; a < 2; ++a)
#pragma unroll
            for (int b = 0; b < 2; ++b)
#pragma unroll
                for (int m = 0; m < 4; ++m)
#pragma unroll
                    for (int n = 0; n < 2; ++n) acc[a][b][m][n] = (f32x4){0.f, 0.f, 0.f, 0.f};
        cur = nxt; cA = nA; cB = nB; ++ui;
        if constexpr (ALIGN_EPI) { if (wr == 1) PG8_BAR; }
    }
    PG8_WAIT_V(0);
    if constexpr (!ALIGN_EPI) { if (wr == 0) PG8_BAR; }
    PG8_BAR;
    if constexpr (Epi::AFTER_DRAIN) { E.fused(acc, cur, wr, wc, fr, fq, lds, wid, lane); S.done(cur); }
#undef PG8_SA
#undef PG8_SB
#undef PG8_STAGE
#undef PG8_LDA
#undef PG8_LDB
#undef PG8_MMA
#undef PG8_WAIT_V
#undef PG8_WAIT_L
#undef PG8_BAR
#undef PG8_SCHED
}
}
#define LAS __attribute__((address_space(3)))
typedef unsigned short bf16;
typedef short bf16x8 __attribute__((ext_vector_type(8)));
typedef short s16x4 __attribute__((ext_vector_type(4)));
typedef float f32x4 __attribute__((ext_vector_type(4)));
typedef float f32x16 __attribute__((ext_vector_type(16)));
typedef unsigned u32x4 __attribute__((ext_vector_type(4)));
typedef unsigned u32x2 __attribute__((ext_vector_type(2)));
typedef LAS unsigned char* lptr;
constexpr int NT = 32768, DM = 1024, SEQ = 2048, NB = 16, NPROJ = 3584, DFF = 4096, MEMR = 4096;
constexpr float EPS = 1e-6f, LOG2E = 1.4426950408889634f;
constexpr size_t MiB = 1u << 20;
constexpr size_t WS_CTL = 0, WS_SSQ1 = 1 * MiB, WS_SSQ2 = 1 * MiB + 131072, WS_GATES = 2 * MiB, WS_CK = 4 * MiB, WS_GL = 5 * MiB;
constexpr size_t WS_WIN = 6 * MiB, WS_WOUT = 13 * MiB, WS_WCQ = 15 * MiB, WS_WCKV = 16 * MiB, WS_WCO = 18 * MiB, WS_W1 = 19 * MiB, WS_W2 = 27 * MiB;
constexpr size_t WS_HM = 35 * MiB, WS_CKV = 43 * MiB, WS_BUFA = 52 * MiB, WS_BIG = 116 * MiB;
constexpr size_t WS_PROJ = WS_BIG, WS_GP = WS_BIG + 224 * MiB, WS_XB1 = WS_BIG, WS_CQ = WS_BIG + 64 * MiB, WS_CO = WS_BIG + 96 * MiB, WS_HMID = WS_BIG;
constexpr size_t WS_END = WS_GP + 144 * MiB;
constexpr int GP_CHUNK = 73728, GP_W = 0, GP_QG = 16384, GP_KDT = 32768, GP_UT = 49152, GP_IN = 65536;
constexpr int LDS_BYTES = 147456, LDS_MISC = LDS_BYTES - 64;
constexpr int NPH = 10;

__device__ __forceinline__ float bflo(unsigned u) { return __uint_as_float(u << 16); }
__device__ __forceinline__ float bfhi(unsigned u) { return __uint_as_float(u & 0xffff0000u); }
typedef float f32x2_t __attribute__((ext_vector_type(2))); typedef __bf16 bf16x2_t __attribute__((ext_vector_type(2)));
__device__ __forceinline__ unsigned pk2(float lo, float hi) { f32x2_t v = {lo, hi}; bf16x2_t b = __builtin_convertvector(v, bf16x2_t); return __builtin_bit_cast(unsigned, b); }
__device__ __forceinline__ unsigned pk2v(float lo, float hi) { return pg8::cvt_pk_bf16(lo, hi); }
__device__ __forceinline__ f32x4 mfma16(bf16x8 a, bf16x8 b, f32x4 c) { return __builtin_amdgcn_mfma_f32_16x16x32_bf16(a, b, c, 0, 0, 0); }
__device__ __forceinline__ f32x16 mfma32(bf16x8 a, bf16x8 b, f32x16 c) { return __builtin_amdgcn_mfma_f32_32x32x16_bf16(a, b, c, 0, 0, 0); }
__device__ __forceinline__ bf16x8 lds8(lptr p) { return *(const LAS bf16x8*)p; }
__device__ __forceinline__ float wave_sum(float v) {
#pragma unroll
    for (int o = 1; o < 64; o <<= 1) v += __shfl_xor(v, o);
    return v;
}
#define LDS_WAIT() asm volatile("s_waitcnt lgkmcnt(0)" ::: "memory")
__device__ __forceinline__ float siluf(float y) { return y / (1.f + __expf(-y)); }
__device__ __forceinline__ float softplusf(float z) { return fmaxf(z, 0.f) + log1pf(__expf(-fabsf(z))); }

__device__ __forceinline__ void transpose_item(const float* W, int K, int Ntot, int col0, int ncols, bf16* WT, int row_off, const float* gain, LAS float* scr, int item, int lane) {
    const int nblk = ncols / 32, kb = item / nblk, nb = item % nblk, k0 = 64 * kb, n0 = 32 * nb;
#pragma unroll 8
    for (int i = 0; i < 32; ++i) { const int kk = 2 * i + (lane >> 5); float v = W[(size_t)(k0 + kk) * Ntot + col0 + n0 + (lane & 31)]; if (gain) v *= gain[k0 + kk]; scr[kk * 33 + (lane & 31)] = v; }
    LDS_WAIT();
    const int c = lane & 7;
#pragma unroll
    for (int j = 0; j < 4; ++j) { const int n = (lane >> 3) + 8 * j; const LAS float* s = scr + (8 * c) * 33 + n;
        u32x4 o; o.x = pk2v(s[0 * 33], s[1 * 33]); o.y = pk2v(s[2 * 33], s[3 * 33]); o.z = pk2v(s[4 * 33], s[5 * 33]); o.w = pk2v(s[6 * 33], s[7 * 33]);
        *(u32x4*)(WT + (size_t)(row_off + n0 + n) * K + k0 + 8 * c) = o; }
    LDS_WAIT();
}
struct P { const float* in[23]; float* out; unsigned char* ws; };

template <bool GATES>
__device__ __forceinline__ void norm_row(const P& p, const float* xrow, const float* g, bf16* orow, float* gates_row, const LAS float* w16, int lane) {
    const f32x4* xr = (const f32x4*)xrow + lane; const f32x4* gr = (const f32x4*)g + lane;
    f32x4 v[4]; float s = 0.f;
#pragma unroll
    for (int j = 0; j < 4; ++j) { v[j] = xr[64 * j]; s += (v[j].x * v[j].x + v[j].y * v[j].y) + (v[j].z * v[j].z + v[j].w * v[j].w); }
    const float rstd = rsqrtf(wave_sum(s) * (1.f / DM) + EPS);
    unsigned long long* o8 = (unsigned long long*)orow + lane;
#pragma unroll
    for (int j = 0; j < 4; ++j) { v[j] = v[j] * rstd * gr[64 * j]; o8[64 * j] = (unsigned long long)pk2v(v[j].x, v[j].y) | ((unsigned long long)pk2v(v[j].z, v[j].w) << 32); }
    if (GATES) {
        float mine = 0.f;
#pragma unroll
        for (int c = 0; c < 16; ++c) {
            float d = 0.f;
#pragma unroll
            for (int j = 0; j < 4; ++j) { const f32x4 w4 = *(const LAS f32x4*)(w16 + c * 1024 + 256 * j + 4 * lane); d += (v[j].x * w4.x + v[j].y * w4.y) + (v[j].z * w4.z + v[j].w * w4.w); }
            d = wave_sum(d);
            mine = (lane == c) ? d : mine;
        }
        if (lane < 16) {
            float r;
            if (lane < 8) { const float z = mine + p.in[6][lane]; r = -softplusf(-z); }
            else if (lane < 12) { r = 1.f / (1.f + __expf(-mine)); }
            else { r = -__expf(p.in[9][lane - 12]) * softplusf(mine + p.in[10][lane - 12]); }
            gates_row[lane] = r;
        }
    }
}

__device__ __forceinline__ void p0_prologue(const P& p, lptr lds, int G) {
    const int tid = threadIdx.x, lane = tid & 63, wave = tid >> 6;
    const int gw = blockIdx.x * 8 + wave, NGW = G * 8;
    unsigned char* ws = p.ws;
    for (int i = blockIdx.x * 512 + tid; i < 2 * NT; i += G * 512) ((float*)(ws + WS_SSQ1))[i] = 0.f;
    if (blockIdx.x == 0 && tid < 64) ((unsigned*)(ws + WS_CTL))[tid] = 0u;
    LAS float* w16 = (LAS float*)lds;
    for (int i = tid; i < 16 * 1024; i += 512) { const int k = i >> 4, c = i & 15; const int col = c < 8 ? 1536 + c : 3072 + c; w16[c * 1024 + k] = p.in[3][(size_t)k * 3600 + col]; }
    LAS float* scr = (LAS float*)(lds + 65536 + wave * 8448);
    constexpr int I0 = 16 * 48, I1 = 16 * 48, I2 = 16 * 16, I3 = 16 * 32, I4 = 16 * 16, I5 = 16 * 32, I6 = 8 * 32, I7 = 16 * 128, I8 = 64 * 32;
    constexpr int NITEMS = I0 + I1 + I2 + I3 + I4 + I5 + I6 + I7 + I8;
    for (int it = gw; it < NITEMS; it += NGW) {
        int r = it;
        if (r < I0) { transpose_item(p.in[3], 1024, 3600, 0, 1536, (bf16*)(ws + WS_WIN), 0, nullptr, scr, r, lane); continue; } r -= I0;
        if (r < I1) { transpose_item(p.in[3], 1024, 3600, 1544, 1536, (bf16*)(ws + WS_WIN), 1536, nullptr, scr, r, lane); continue; } r -= I1;
        if (r < I2) { transpose_item(p.in[3], 1024, 3600, 3088, 512, (bf16*)(ws + WS_WIN), 3072, nullptr, scr, r, lane); continue; } r -= I2;
        if (r < I3) { transpose_item(p.in[12], 1024, 1024, 0, 1024, (bf16*)(ws + WS_WOUT), 0, nullptr, scr, r, lane); continue; } r -= I3;
        if (r < I4) { transpose_item(p.in[15], 1024, 512, 0, 512, (bf16*)(ws + WS_WCQ), 0, p.in[13], scr, r, lane); continue; } r -= I4;
        if (r < I5) { transpose_item(p.in[16], 1024, 1024, 0, 1024, (bf16*)(ws + WS_WCKV), 0, nullptr, scr, r, lane); continue; } r -= I5;
        if (r < I6) { transpose_item(p.in[19], 512, 1024, 0, 1024, (bf16*)(ws + WS_WCO), 0, nullptr, scr, r, lane); continue; } r -= I6;
        if (r < I7) { transpose_item(p.in[21], 1024, 4096, 0, 4096, (bf16*)(ws + WS_W1), 0, p.in[20], scr, r, lane); continue; } r -= I7;
        transpose_item(p.in[22], 4096, 1024, 0, 1024, (bf16*)(ws + WS_W2), 0, nullptr, scr, r, lane);
    }
    __syncthreads();
    for (int m = gw; m < NT; m += NGW) norm_row<true>(p, p.in[0] + (size_t)m * DM, p.in[2], (bf16*)(ws + WS_BUFA) + (size_t)m * DM, (float*)(ws + WS_GATES) + (size_t)m * 16, w16, lane);
    for (int m = gw; m < MEMR; m += NGW) norm_row<false>(p, p.in[1] + (size_t)m * DM, p.in[14], (bf16*)(ws + WS_HM) + (size_t)m * DM, nullptr, w16, lane);
    __syncthreads();
}
constexpr int PQ_KN = 0, PQ_QS = 17408, PQ_VBT = 34816, PQ_KBGT = 53248, PQ_KDT = 71680, PQ_LM = 90112, PQ_TM = 106496, PQ_GC = 115712, PQ_BETA = 115968;

__device__ __forceinline__ void gdn_prep_task(const P& p, lptr lds, int cid) {
    int tid_ = threadIdx.x; asm volatile("" : "+v"(tid_));
    const int tid = tid_, lane = tid & 63, wave = __builtin_amdgcn_readfirstlane(tid >> 6), fr = lane & 15, fg = lane >> 4;
    const int b = cid >> 7, h = (cid >> 5) & 3, n = cid & 31;
    const int R0 = b * SEQ + n * 64;
    unsigned char* ws = p.ws;
    const float* gates = (const float*)(ws + WS_GATES);
    const bf16* proj = (const bf16*)(ws + WS_PROJ);
    unsigned char* gp = ws + WS_GP + (size_t)cid * GP_CHUNK;
    float gcl = gates[(size_t)(R0 + lane) * 16 + 12 + h];
    const float betal = gates[(size_t)(R0 + lane) * 16 + 8 + h];
#pragma unroll
    for (int o = 1; o < 64; o <<= 1) { const float t = __shfl_up(gcl, o); if (lane >= o) gcl += t; }
    const float glast = __shfl(gcl, 63);
    if (wave == 0) { ((LAS float*)(lds + PQ_GC))[lane] = gcl; ((LAS float*)(lds + PQ_BETA))[lane] = betal; if (lane == 0) ((float*)(ws + WS_GL))[cid] = __expf(glast); }
    float gcr[8], betar[8];
#pragma unroll
    for (int rr = 0; rr < 8; ++rr) { gcr[rr] = __shfl(gcl, wave * 8 + rr); betar[rr] = __shfl(betal, wave * 8 + rr); }
#ifndef NO_S1
    if (lane < 48) {
        const int sec = lane >> 4, oc = lane & 15;
        const int pcol = 1536 + sec * 512 + h * 128 + oc * 8, cc = sec * 512 + h * 128 + oc * 8;
        u32x4 raw[11];
#pragma unroll
        for (int i = 0; i < 11; ++i) {
            const int ts = n * 64 + wave * 8 - 3 + i;
            raw[i] = (u32x4){0u, 0u, 0u, 0u};
            if (ts >= 0) raw[i] = *(const u32x4*)(proj + (size_t)(b * SEQ + ts) * NPROJ + pcol);
        }
        float cw[4][8];
#pragma unroll
        for (int j = 0; j < 4; ++j) { const f32x4 a = *(const f32x4*)(p.in[8] + j * 1536 + cc), c2 = *(const f32x4*)(p.in[8] + j * 1536 + cc + 4);
            cw[j][0] = a.x; cw[j][1] = a.y; cw[j][2] = a.z; cw[j][3] = a.w; cw[j][4] = c2.x; cw[j][5] = c2.y; cw[j][6] = c2.z; cw[j][7] = c2.w; }
#pragma unroll
        for (int rr = 0; rr < 8; ++rr) {
            const int r = wave * 8 + rr;
            float y[8]; float ss = 0.f;
#pragma unroll
            for (int ch = 0; ch < 8; ++ch) {
                float a = 0.f;
#pragma unroll
                for (int j = 0; j < 4; ++j) { const unsigned wd = raw[rr + j][ch >> 1]; a += cw[j][ch] * ((ch & 1) ? bfhi(wd) : bflo(wd)); }
                a = siluf(a); y[ch] = a; ss += a * a; }
            ss += __shfl_xor(ss, 1); ss += __shfl_xor(ss, 2); ss += __shfl_xor(ss, 4); ss += __shfl_xor(ss, 8);
            const float rn = rsqrtf(ss + EPS);
            const float eg = __expf(gcr[rr]), bt = betar[rr];
            if (sec == 0) {
                const float sc = rn * 0.08838834764831845f;
                u32x4 o; o.x = pk2(y[0] * sc, y[1] * sc); o.y = pk2(y[2] * sc, y[3] * sc); o.z = pk2(y[4] * sc, y[5] * sc); o.w = pk2(y[6] * sc, y[7] * sc);
                *(LAS u32x4*)(lds + PQ_QS + r * 272 + oc * 16) = o;
                const float s2 = sc * eg;
                u32x4 o2; o2.x = pk2(y[0] * s2, y[1] * s2); o2.y = pk2(y[2] * s2, y[3] * s2); o2.z = pk2(y[4] * s2, y[5] * s2); o2.w = pk2(y[6] * s2, y[7] * s2);
                *(u32x4*)(gp + GP_QG + r * 256 + oc * 16) = o2;
            } else if (sec == 1) {
                u32x4 o; o.x = pk2(y[0] * rn, y[1] * rn); o.y = pk2(y[2] * rn, y[3] * rn); o.z = pk2(y[4] * rn, y[5] * rn); o.w = pk2(y[6] * rn, y[7] * rn);
                *(LAS u32x4*)(lds + PQ_KN + r * 272 + oc * 16) = o;
                const float s1 = rn * bt * eg, s2 = rn * __expf(glast - gcr[rr]);
#pragma unroll
                for (int ch = 0; ch < 8; ++ch) {
                    *(LAS bf16*)(lds + PQ_KBGT + (oc * 8 + ch) * 144 + r * 2) = (bf16)(pk2(y[ch] * s1, 0.f) & 0xffffu);
                    *(LAS bf16*)(lds + PQ_KDT + (oc * 8 + ch) * 144 + r * 2) = (bf16)(pk2(y[ch] * s2, 0.f) & 0xffffu);
                }
            } else {
#pragma unroll
                for (int ch = 0; ch < 8; ++ch) *(LAS bf16*)(lds + PQ_VBT + (oc * 8 + ch) * 144 + r * 2) = (bf16)(pk2(y[ch] * bt, 0.f) & 0xffffu);
            }
        }
    }
#endif
    __syncthreads();
    {
        const LAS float* GC = (const LAS float*)(lds + PQ_GC); const LAS float* BT = (const LAS float*)(lds + PQ_BETA);
        const int ti = wave >> 1;
#pragma unroll
        for (int q = 0; q < 2; ++q) {
            const int tj = (wave & 1) * 2 + q;
            if (tj <= ti) {
                f32x4 c = (f32x4){0.f, 0.f, 0.f, 0.f};
#pragma unroll
                for (int kk = 0; kk < 4; ++kk) c = mfma16(lds8(lds + PQ_KN + (16 * ti + fr) * 272 + (32 * kk + 8 * fg) * 2), lds8(lds + PQ_KN + (16 * tj + fr) * 272 + (32 * kk + 8 * fg) * 2), c);
                const int j = 16 * tj + fr; const float gj = GC[j];
#pragma unroll
                for (int e = 0; e < 4; ++e) { const int i = 16 * ti + 4 * fg + e; const float v = (i > j) ? BT[i] * c[e] * __expf(GC[i] - gj) : 0.f; ((LAS float*)(lds + PQ_LM))[i * 64 + j] = v; }
            }
            {
                const int i = 16 * ti + fr; u32x2 o = (u32x2){0u, 0u};
                if (tj <= ti) {
                    f32x4 c = (f32x4){0.f, 0.f, 0.f, 0.f};
#pragma unroll
                    for (int kk = 0; kk < 4; ++kk) c = mfma16(lds8(lds + PQ_KN + (16 * tj + fr) * 272 + (32 * kk + 8 * fg) * 2), lds8(lds + PQ_QS + (16 * ti + fr) * 272 + (32 * kk + 8 * fg) * 2), c);
                    const float gi = GC[i]; float v[4];
#pragma unroll
                    for (int e = 0; e < 4; ++e) { const int j = 16 * tj + 4 * fg + e; v[e] = (j <= i) ? c[e] * __expf(gi - GC[j]) : 0.f; }
                    o.x = pk2(v[0], v[1]); o.y = pk2(v[2], v[3]);
                }
                *(u32x2*)(gp + GP_IN + i * 128 + (16 * tj + 4 * fg) * 2) = o;
            }
        }
    }
    __syncthreads();
#ifndef NO_S3
    if (wave == 0) {
        float t[64];
        int vz; asm volatile("v_mov_b32 %0, 0" : "=v"(vz));
        const lptr lmb = lds + PQ_LM + vz;
#pragma unroll
        for (int i = 0; i < 64; ++i) {
            asm volatile("" ::: "memory");
            float a0 = (i == lane) ? 1.f : 0.f, a1 = 0.f, a2 = 0.f, a3 = 0.f;
#pragma unroll
            for (int jb = 0; jb < i; jb += 4) {
                if ((jb & 15) == 0 && jb) asm volatile("" ::: "memory");
                const f32x4 l4 = *(const LAS f32x4*)(lmb + (i * 64 + jb) * 4);
                a0 -= l4.x * t[jb];
                if (jb + 1 < i) a1 -= l4.y * t[jb + 1];
                if (jb + 2 < i) a2 -= l4.z * t[jb + 2];
                if (jb + 3 < i) a3 -= l4.w * t[jb + 3];
            }
            t[i] = (a0 + a1) + (a2 + a3);
        }
#pragma unroll
        for (int i = 0; i < 64; ++i) *(LAS bf16*)(lds + PQ_TM + i * 144 + lane * 2) = (bf16)(pk2(t[i], 0.f) & 0xffffu);
    } else {
        for (int q = tid - 64; q < 1024; q += 448) { const int row = q >> 3, c = q & 7; *(u32x4*)(gp + GP_KDT + row * 128 + c * 16) = *(const LAS u32x4*)(lds + PQ_KDT + row * 144 + c * 16); }
    }
#endif
    __syncthreads();
    {
        bf16x8 bv[2], ak[2];
#pragma unroll
        for (int kk = 0; kk < 2; ++kk) { bv[kk] = lds8(lds + PQ_VBT + (16 * wave + fr) * 144 + (32 * kk + 8 * fg) * 2); ak[kk] = lds8(lds + PQ_KBGT + (16 * wave + fr) * 144 + (32 * kk + 8 * fg) * 2); }
#pragma unroll
        for (int ti = 0; ti < 4; ++ti) {
            bf16x8 tm[2];
#pragma unroll
            for (int kk = 0; kk < 2; ++kk) tm[kk] = lds8(lds + PQ_TM + (16 * ti + fr) * 144 + (32 * kk + 8 * fg) * 2);
            f32x4 cu = (f32x4){0.f, 0.f, 0.f, 0.f}, cw2 = (f32x4){0.f, 0.f, 0.f, 0.f};
#pragma unroll
            for (int kk = 0; kk < 2; ++kk) { cu = mfma16(tm[kk], bv[kk], cu); cw2 = mfma16(ak[kk], tm[kk], cw2); }
            u32x2 ou; ou.x = pk2(cu[0], cu[1]); ou.y = pk2(cu[2], cu[3]);
            *(u32x2*)(gp + GP_UT + (16 * wave + fr) * 128 + (16 * ti + 4 * fg) * 2) = ou;
            u32x2 ow; ow.x = pk2(-cw2[0], -cw2[1]); ow.y = pk2(-cw2[2], -cw2[3]);
            *(u32x2*)(gp + GP_W + (16 * ti + fr) * 256 + (16 * wave + 4 * fg) * 2) = ow;
        }
    }
    __syncthreads();
}

template <int GLN>
__device__ __forceinline__ void knorm_row(bf16* rowp, const float* gain, int lane) {
    u32x4 raw = *(const u32x4*)(rowp + lane * 8);
    float y[8] = {bflo(raw.x), bfhi(raw.x), bflo(raw.y), bfhi(raw.y), bflo(raw.z), bfhi(raw.z), bflo(raw.w), bfhi(raw.w)};
    float ss = 0.f;
#pragma unroll
    for (int e = 0; e < 8; ++e) ss += y[e] * y[e];
#pragma unroll
    for (int o = 1; o < GLN; o <<= 1) ss += __shfl_xor(ss, o);
    const float rs = rsqrtf(ss * (1.f / (8 * GLN)) + EPS);
    const float* gp = gain + (lane & (GLN - 1)) * 8;
    const f32x4 g0 = *(const f32x4*)gp, g1 = *(const f32x4*)(gp + 4);
    u32x4 o; o.x = pk2(y[0] * rs * g0.x, y[1] * rs * g0.y); o.y = pk2(y[2] * rs * g0.z, y[3] * rs * g0.w); o.z = pk2(y[4] * rs * g1.x, y[5] * rs * g1.y); o.w = pk2(y[6] * rs * g1.z, y[7] * rs * g1.w);
    *(u32x4*)(rowp + lane * 8) = o;
}

__device__ __forceinline__ void p2_prep(const P& p, lptr lds, int G) {
    const int tid = threadIdx.x, lane = tid & 63, wave = tid >> 6;
    const int gw = blockIdx.x * 8 + wave, NGW = G * 8;
    unsigned char* ws = p.ws;
    for (int m = gw; m < NT; m += NGW) knorm_row<8>((bf16*)(ws + WS_PROJ) + (size_t)m * NPROJ + 512, p.in[5], lane);
    for (int m = gw; m < MEMR; m += NGW) knorm_row<16>((bf16*)(ws + WS_CKV) + (size_t)m * 1024, p.in[18], lane);
    for (int s = gw; s < NB * 8; s += NGW) {
        const int b = s >> 3, h = s & 7; const float* gates = (const float*)(ws + WS_GATES) + (size_t)b * SEQ * 16 + h;
        float v[32]; float run = 0.f;
#pragma unroll
        for (int i = 0; i < 32; ++i) { run += gates[(size_t)(lane * 32 + i) * 16]; v[i] = run; }
        float tot = run;
#pragma unroll
        for (int o = 1; o < 64; o <<= 1) { const float t = __shfl_up(tot, o); if (lane >= o) tot += t; }
        const float off = tot - run;
        float* ck = (float*)(ws + WS_CK) + (size_t)s * SEQ + lane * 32;
#pragma unroll
        for (int i = 0; i < 32; ++i) ck[i] = -(v[i] + off) * LOG2E;
    }
    for (int cid = blockIdx.x; cid < 2048; cid += G) gdn_prep_task(p, lds, cid);
}
constexpr int SC_WL = 0, SC_QGL = 17408, SC_KDL = 34816, SC_UTL = 53248, SC_INL = 71680, SC_ST = 80896, SC_VNT = 115712, SC_SSQ = 134144, SC_RSTD = 136192;

__device__ __forceinline__ void gdn_scan_task(const P& p, lptr lds, int tsk) {
    int tid_ = threadIdx.x; asm volatile("" : "+v"(tid_));
    const int tid = tid_, lane = tid & 63, wave = __builtin_amdgcn_readfirstlane(tid >> 6), fr = lane & 15, fg = lane >> 4;
    const int b = tsk >> 2, h = tsk & 3;
    unsigned char* ws = p.ws;
    const unsigned char* gp0 = ws + WS_GP + (size_t)tsk * 32 * GP_CHUNK;
    const float* GL = (const float*)(ws + WS_GL) + tsk * 32;
    const bf16* proj = (const bf16*)(ws + WS_PROJ);
    bf16* mix = (bf16*)(ws + WS_BUFA);
    const int ecol = 16 * wave + fr;
    const float og = p.in[11][ecol];
    u32x4 pf[9];
    auto issue = [&](int n) {
        const unsigned char* g = gp0 + (size_t)n * GP_CHUNK;
#pragma unroll
        for (int k = 0; k < 2; ++k) { pf[k] = *(const u32x4*)(g + GP_W + (tid + 512 * k) * 16); pf[2 + k] = *(const u32x4*)(g + GP_QG + (tid + 512 * k) * 16);
            pf[4 + k] = *(const u32x4*)(g + GP_KDT + (tid + 512 * k) * 16); pf[6 + k] = *(const u32x4*)(g + GP_UT + (tid + 512 * k) * 16); }
        pf[8] = *(const u32x4*)(g + GP_IN + tid * 16);
    };
    auto commit = [&]() {
#pragma unroll
        for (int k = 0; k < 2; ++k) { const int q = tid + 512 * k;
            *(LAS u32x4*)(lds + SC_WL + (q >> 4) * 272 + (q & 15) * 16) = pf[k]; *(LAS u32x4*)(lds + SC_QGL + (q >> 4) * 272 + (q & 15) * 16) = pf[2 + k];
            *(LAS u32x4*)(lds + SC_KDL + (q >> 3) * 144 + (q & 7) * 16) = pf[4 + k]; *(LAS u32x4*)(lds + SC_UTL + (q >> 3) * 144 + (q & 7) * 16) = pf[6 + k]; }
        *(LAS u32x4*)(lds + SC_INL + (tid >> 3) * 144 + (tid & 7) * 16) = pf[8];
    };
    f32x4 sacc[8];
#pragma unroll
    for (int td = 0; td < 8; ++td) sacc[td] = (f32x4){0.f, 0.f, 0.f, 0.f};
    for (int q = lane; q < 272; q += 64) *(LAS u32x4*)(lds + SC_ST + (16 * wave) * 272 + q * 16) = (u32x4){0u, 0u, 0u, 0u};
    issue(0); commit();
    __syncthreads();
    for (int n = 0; n < 32; ++n) {
        if (n + 1 < 32) issue(n + 1);
        const float eg = GL[n];
        bf16x8 bs[4];
#pragma unroll
        for (int kk = 0; kk < 4; ++kk) bs[kk] = lds8(lds + SC_ST + ecol * 272 + (32 * kk + 8 * fg) * 2);
        f32x4 acc[4];
#pragma unroll
        for (int ti = 0; ti < 4; ++ti) {
            const u32x2 uu = *(const LAS u32x2*)(lds + SC_UTL + ecol * 144 + (16 * ti + 4 * fg) * 2);
            acc[ti] = (f32x4){bflo(uu.x), bfhi(uu.x), bflo(uu.y), bfhi(uu.y)};
#pragma unroll
            for (int kk = 0; kk < 4; ++kk) acc[ti] = mfma16(lds8(lds + SC_WL + (16 * ti + fr) * 272 + (32 * kk + 8 * fg) * 2), bs[kk], acc[ti]);
            u32x2 o; o.x = pk2(acc[ti][0], acc[ti][1]); o.y = pk2(acc[ti][2], acc[ti][3]);
            *(LAS u32x2*)(lds + SC_VNT + ecol * 144 + (16 * ti + 4 * fg) * 2) = o;
        }
        LDS_WAIT();
        bf16x8 vn[2];
#pragma unroll
        for (int kk = 0; kk < 2; ++kk) vn[kk] = lds8(lds + SC_VNT + ecol * 144 + (32 * kk + 8 * fg) * 2);
        f32x4 oacc[4];
#pragma unroll
        for (int ti = 0; ti < 4; ++ti) {
            oacc[ti] = (f32x4){0.f, 0.f, 0.f, 0.f};
#pragma unroll
            for (int kk = 0; kk < 4; ++kk) oacc[ti] = mfma16(lds8(lds + SC_QGL + (16 * ti + fr) * 272 + (32 * kk + 8 * fg) * 2), bs[kk], oacc[ti]);
#pragma unroll
            for (int kk = 0; kk < 2; ++kk) oacc[ti] = mfma16(lds8(lds + SC_INL + (16 * ti + fr) * 144 + (32 * kk + 8 * fg) * 2), vn[kk], oacc[ti]);
        }
#pragma unroll
        for (int td = 0; td < 8; ++td) {
            sacc[td] = sacc[td] * eg;
#pragma unroll
            for (int kk = 0; kk < 2; ++kk) sacc[td] = mfma16(lds8(lds + SC_KDL + (16 * td + fr) * 144 + (32 * kk + 8 * fg) * 2), vn[kk], sacc[td]);
            u32x2 o; o.x = pk2(sacc[td][0], sacc[td][1]); o.y = pk2(sacc[td][2], sacc[td][3]);
            *(LAS u32x2*)(lds + SC_ST + ecol * 272 + (16 * td + 4 * fg) * 2) = o;
        }
#pragma unroll
        for (int ti = 0; ti < 4; ++ti)
#pragma unroll
            for (int e = 0; e < 4; ++e) {
                float s = oacc[ti][e] * oacc[ti][e];
                s += __shfl_xor(s, 1); s += __shfl_xor(s, 2); s += __shfl_xor(s, 4); s += __shfl_xor(s, 8);
                if (fr == 0) ((LAS float*)(lds + SC_SSQ))[wave * 64 + 16 * ti + 4 * fg + e] = s;
            }
        __syncthreads();
        if (n + 1 < 32) commit();
        if (tid < 64) { float s = 0.f;
#pragma unroll
            for (int w = 0; w < 8; ++w) s += ((const LAS float*)(lds + SC_SSQ))[w * 64 + tid];
            ((LAS float*)(lds + SC_RSTD))[tid] = rsqrtf(s * (1.f / 128.f) + EPS); }
        const size_t trow0 = (size_t)b * SEQ + n * 64;
        unsigned short zr[16];
#pragma unroll
        for (int ti = 0; ti < 4; ++ti)
#pragma unroll
            for (int e = 0; e < 4; ++e) zr[ti * 4 + e] = proj[(trow0 + 16 * ti + 4 * fg + e) * NPROJ + 3072 + h * 128 + ecol];
        __syncthreads();
#pragma unroll
        for (int ti = 0; ti < 4; ++ti) {
            const f32x4 rs = *(const LAS f32x4*)(lds + SC_RSTD + (16 * ti + 4 * fg) * 4);
#pragma unroll
            for (int e = 0; e < 4; ++e) {
                const float z = __uint_as_float((unsigned)zr[ti * 4 + e] << 16);
                const float v = oacc[ti][e] * rs[e] * og * siluf(z);
                mix[(trow0 + 16 * ti + 4 * fg + e) * DM + 512 + h * 128 + ecol] = (bf16)(pk2(v, 0.f) & 0xffffu);
            }
        }
    }
    __syncthreads();
}

constexpr int AT_ALPHA = 70144, AT_OST = 73728;
__device__ __forceinline__ int crow(int r, int hi) { return (r & 3) + 8 * (r >> 2) + 4 * hi; }
typedef short v4i16_t __attribute__((ext_vector_type(4)));
__device__ __forceinline__ s16x4 vtr(lptr pv) { return __builtin_bit_cast(s16x4, __builtin_amdgcn_ds_read_tr16_b64_v4i16((LAS v4i16_t*)pv)); }

template <int D, bool FOX>
__device__ __forceinline__ void attn_unit(lptr lds, const bf16* Qp, int qpitch, const bf16* Kp, const bf16* Vp, int kvpitch, int ntiles, int q0,
                                          const float* qgain, float qscale, const float* bias, bf16* Op, int opitch, const float* ogain) {
    constexpr int PITCH = D * 2 + 16, TILEB = 64 * PITCH, ND = D / 16, NDB = D / 32, NCH = D / 64;
    constexpr int OFF_K = 0, OFF_V = 2 * TILEB, OFF_B = 4 * TILEB;
    int tid_ = threadIdx.x; asm volatile("" : "+v"(tid_));
    const int tid = tid_, lane = tid & 63, wave = __builtin_amdgcn_readfirstlane(tid >> 6), r32 = lane & 31, hi = lane >> 5;
    bf16x8 qf[ND];
    {
        const bf16* qrow = Qp + (size_t)(32 * wave + r32) * qpitch;
        float qv[ND][8]; float ss = 0.f;
#pragma unroll
        for (int d0 = 0; d0 < ND; ++d0) { const u32x4 raw = *(const u32x4*)(qrow + 16 * d0 + 8 * hi);
            qv[d0][0] = bflo(raw.x); qv[d0][1] = bfhi(raw.x); qv[d0][2] = bflo(raw.y); qv[d0][3] = bfhi(raw.y); qv[d0][4] = bflo(raw.z); qv[d0][5] = bfhi(raw.z); qv[d0][6] = bflo(raw.w); qv[d0][7] = bfhi(raw.w);
#pragma unroll
            for (int e = 0; e < 8; ++e) ss += qv[d0][e] * qv[d0][e]; }
        ss += __shfl_xor(ss, 32);
        const float rs = rsqrtf(ss * (1.f / D) + EPS) * qscale;
#pragma unroll
        for (int d0 = 0; d0 < ND; ++d0) { const f32x4 g0 = *(const f32x4*)(qgain + 16 * d0 + 8 * hi), g1 = *(const f32x4*)(qgain + 16 * d0 + 8 * hi + 4);
            u32x4 o; o.x = pk2(qv[d0][0] * rs * g0.x, qv[d0][1] * rs * g0.y); o.y = pk2(qv[d0][2] * rs * g0.z, qv[d0][3] * rs * g0.w);
            o.z = pk2(qv[d0][4] * rs * g1.x, qv[d0][5] * rs * g1.y); o.w = pk2(qv[d0][6] * rs * g1.z, qv[d0][7] * rs * g1.w);
            qf[d0] = __builtin_bit_cast(bf16x8, o); }
    }
    f32x16 o[NDB];
#pragma unroll
    for (int db = 0; db < NDB; ++db) o[db] = f32x16{};
    float mrun = -INFINITY, lrun = 0.f;
    const int wave_last = FOX ? ((q0 + 32 * wave + 31) >> 6) : (ntiles - 1);
    const int qpos = q0 + 32 * wave + r32;
    u32x4 kr[NCH], vr[NCH]; float br = 0.f;
    auto issue = [&](int kt) {
#pragma unroll
        for (int c = 0; c < NCH; ++c) { const int q = tid + 512 * c, row = q / (D / 8), cc = q % (D / 8);
            kr[c] = *(const u32x4*)(Kp + (size_t)(kt * 64 + row) * kvpitch + cc * 8); vr[c] = *(const u32x4*)(Vp + (size_t)(kt * 64 + row) * kvpitch + cc * 8); }
        if (FOX && tid < 64) br = bias[kt * 64 + tid];
    };
    auto commit = [&](int buf) {
#pragma unroll
        for (int c = 0; c < NCH; ++c) { const int q = tid + 512 * c, row = q / (D / 8), cc = q % (D / 8);
            *(LAS u32x4*)(lds + OFF_K + buf * TILEB + row * PITCH + cc * 16) = kr[c]; *(LAS u32x4*)(lds + OFF_V + buf * TILEB + row * PITCH + cc * 16) = vr[c]; }
        if (FOX && tid < 64) ((LAS float*)(lds + OFF_B + buf * 256))[tid] = br;
    };
    LAS float* alpha = (LAS float*)(lds + AT_ALPHA + wave * 128);
    issue(0); commit(0);
    __syncthreads();
    for (int kt = 0; kt < ntiles; ++kt) {
        const int buf = kt & 1;
        if (kt + 1 < ntiles) issue(kt + 1);
        if (kt <= wave_last) {
            f32x16 p0, p1;
            if (FOX) {
#pragma unroll
                for (int a = 0; a < 4; ++a) { const f32x4 b0 = *(const LAS f32x4*)(lds + OFF_B + buf * 256 + (8 * a + 4 * hi) * 4), b1 = *(const LAS f32x4*)(lds + OFF_B + buf * 256 + (32 + 8 * a + 4 * hi) * 4);
#pragma unroll
                    for (int e = 0; e < 4; ++e) { p0[4 * a + e] = b0[e]; p1[4 * a + e] = b1[e]; } }
            } else { p0 = f32x16{}; p1 = f32x16{}; }
            const lptr kb = lds + OFF_K + buf * TILEB + r32 * PITCH + hi * 16;
#pragma unroll
            for (int d0 = 0; d0 < ND; ++d0) { p0 = mfma32(lds8(kb + d0 * 32), qf[d0], p0); p1 = mfma32(lds8(kb + 32 * PITCH + d0 * 32), qf[d0], p1); }
            if (FOX && (kt * 64 + 63 > q0 + 32 * wave)) {
#pragma unroll
                for (int r = 0; r < 16; ++r) { const int key = kt * 64 + crow(r, hi); if (key > qpos) p0[r] = -INFINITY; if (key + 32 > qpos) p1[r] = -INFINITY; }
            }
            float mx = p0[0];
#pragma unroll
            for (int r = 1; r < 16; ++r) mx = fmaxf(mx, p0[r]);
#pragma unroll
            for (int r = 0; r < 16; ++r) mx = fmaxf(mx, p1[r]);
            mx = fmaxf(mx, __shfl_xor(mx, 32));
            const float mnew = fmaxf(mrun, mx);
            const float al = __builtin_amdgcn_exp2f(mrun - mnew);
            mrun = mnew;
            float ls = 0.f;
#pragma unroll
            for (int r = 0; r < 16; ++r) { p0[r] = __builtin_amdgcn_exp2f(p0[r] - mnew); p1[r] = __builtin_amdgcn_exp2f(p1[r] - mnew); ls += p0[r] + p1[r]; }
            lrun = lrun * al + ls;
            bf16x8 pa[4];
            { u32x4 w;
              w.x = pk2(p0[0], p0[1]); w.y = pk2(p0[2], p0[3]); w.z = pk2(p0[4], p0[5]); w.w = pk2(p0[6], p0[7]); pa[0] = __builtin_bit_cast(bf16x8, w);
              w.x = pk2(p0[8], p0[9]); w.y = pk2(p0[10], p0[11]); w.z = pk2(p0[12], p0[13]); w.w = pk2(p0[14], p0[15]); pa[1] = __builtin_bit_cast(bf16x8, w);
              w.x = pk2(p1[0], p1[1]); w.y = pk2(p1[2], p1[3]); w.z = pk2(p1[4], p1[5]); w.w = pk2(p1[6], p1[7]); pa[2] = __builtin_bit_cast(bf16x8, w);
              w.x = pk2(p1[8], p1[9]); w.y = pk2(p1[10], p1[11]); w.z = pk2(p1[12], p1[13]); w.w = pk2(p1[14], p1[15]); pa[3] = __builtin_bit_cast(bf16x8, w); }
            if (hi == 0) alpha[r32] = al;
            LDS_WAIT();
#pragma unroll
            for (int a = 0; a < 4; ++a) { const f32x4 a4 = *(const LAS f32x4*)((lptr)alpha + (8 * a + 4 * hi) * 4);
#pragma unroll
                for (int db = 0; db < NDB; ++db)
#pragma unroll
                    for (int e = 0; e < 4; ++e) o[db][4 * a + e] *= a4[e]; }
            const lptr vb = lds + OFF_V + buf * TILEB + (4 * hi + ((lane & 15) >> 2)) * PITCH + (((lane >> 4) & 1) * 16 + (lane & 3) * 4) * 2;
#pragma unroll
            for (int db = 0; db < NDB; ++db)
#pragma unroll
                for (int s = 0; s < 4; ++s) {
                    const s16x4 lo = vtr(vb + (16 * s) * PITCH + db * 64), hh = vtr(vb + (16 * s + 8) * PITCH + db * 64);
                    const bf16x8 vf = (bf16x8){lo[0], lo[1], lo[2], lo[3], hh[0], hh[1], hh[2], hh[3]};
                    o[db] = mfma32(pa[s], vf, o[db]);
                }
        }
        if (kt + 1 < ntiles) commit(buf ^ 1);
        __syncthreads();
    }
    lrun += __shfl_xor(lrun, 32);
    if (hi == 0) alpha[r32] = 1.f / lrun;
    LDS_WAIT();
    f32x4 inv[4];
#pragma unroll
    for (int a = 0; a < 4; ++a) inv[a] = *(const LAS f32x4*)((lptr)alpha + (8 * a + 4 * hi) * 4);
    LAS float* ost = (LAS float*)(lds + AT_OST + wave * 8704);
#pragma unroll
    for (int ps = 0; ps < NDB / 2; ++ps) {
#pragma unroll
        for (int dbl = 0; dbl < 2; ++dbl)
#pragma unroll
            for (int r = 0; r < 16; ++r) ost[crow(r, hi) * 68 + dbl * 32 + r32] = o[ps * 2 + dbl][r] * inv[r >> 2][r & 3];
        LDS_WAIT();
        const int q = lane >> 1, half = lane & 1;
        float v[32]; float ss = 0.f;
#pragma unroll
        for (int c = 0; c < 8; ++c) { const f32x4 t = *(const LAS f32x4*)((lptr)ost + (q * 68 + half * 32 + 4 * c) * 4); v[4 * c] = t.x; v[4 * c + 1] = t.y; v[4 * c + 2] = t.z; v[4 * c + 3] = t.w; }
        float rs = 1.f;
        if (FOX) {
#pragma unroll
            for (int e = 0; e < 32; ++e) ss += v[e] * v[e];
            ss += __shfl_xor(ss, 1);
            rs = rsqrtf(ss * (1.f / 64.f) + EPS);
        }
        bf16* op = Op + (size_t)(32 * wave + q) * opitch + ps * 64 + half * 32;
#pragma unroll
        for (int c = 0; c < 4; ++c) {
            float g[8];
#pragma unroll
            for (int e = 0; e < 8; ++e) g[e] = FOX ? ogain[half * 32 + 8 * c + e] * rs : 1.f;
            u32x4 w; w.x = pk2(v[8 * c] * g[0], v[8 * c + 1] * g[1]); w.y = pk2(v[8 * c + 2] * g[2], v[8 * c + 3] * g[3]); w.z = pk2(v[8 * c + 4] * g[4], v[8 * c + 5] * g[5]); w.w = pk2(v[8 * c + 6] * g[6], v[8 * c + 7] * g[7]);
            *(u32x4*)(op + 8 * c) = w;
        }
        LDS_WAIT();
    }
    __syncthreads();
}
struct Args { P p; int ph_lo, ph_hi; };

__global__ void __launch_bounds__(512, 2) fwd(Args a) {
    extern __shared__ __attribute__((aligned(16))) unsigned char lds_raw[];
    const lptr lds = (lptr)lds_raw;
    const P& p = a.p;
    const int G = gridDim.x, tid = threadIdx.x;
    unsigned char* ws = p.ws;
    cg::grid_group grid = cg::this_grid();
    const int lo = a.ph_lo, hi = a.ph_hi;
#ifndef PH_MASK
#define PH_MASK 0x3ff
#endif
#define IN(k) (((PH_MASK >> (k)) & 1) && lo <= (k) && (k) < hi)
#define SEAM(k) do { if (IN((k) + 1)) grid.sync(); } while (0)
    typedef pg8::bf16_t pb;
    if (IN(0)) { p0_prologue(p, lds, G); SEAM(0); }
    if (IN(1)) {
        { pg8::Gemm g{(const pb*)(ws + WS_BUFA), (const pb*)(ws + WS_WIN), NT, NPROJ, DM}; pg8::StaticOrder S; S.init(NT, NPROJ, G, (int)blockIdx.x);
          pg8::EpiStore<0, false> E{(pb*)(ws + WS_PROJ), NPROJ, nullptr};
          pg8::gemm_phase<pg8::EpiStore<0, false>, pg8::StaticOrder, true, true>(lds, g, S, E); }
        { pg8::Gemm g{(const pb*)(ws + WS_HM), (const pb*)(ws + WS_WCKV), MEMR, 1024, DM}; pg8::StaticOrder S; S.init(MEMR, 1024, G, (G - 1) - (int)blockIdx.x);
          pg8::EpiStore<0, false> E{(pb*)(ws + WS_CKV), 1024, nullptr};
          pg8::gemm_phase<pg8::EpiStore<0, false>, pg8::StaticOrder, true, true>(lds, g, S, E); }
        SEAM(1);
    }
    if (IN(2)) { p2_prep(p, lds, G); SEAM(2); }
    if (IN(3)) {
        unsigned* ctr = (unsigned*)(ws + WS_CTL);
        volatile LAS unsigned* slot = (volatile LAS unsigned*)(lds + LDS_MISC);
        for (;;) {
            __syncthreads();
            if (tid == 0) *slot = atomicAdd(ctr, 1u);
            __syncthreads();
            const unsigned id = *slot;
            if (id >= 64u + 1024u) break;
            if (id < 64u) { gdn_scan_task(p, lds, (int)id); }
            else {
                const int idx = (int)id - 64, qb = 7 - (idx >> 7), bh = idx & 127, b = bh >> 3, h = bh & 7;
                const bf16* proj = (const bf16*)(ws + WS_PROJ);
                const size_t r0 = (size_t)b * SEQ;
                attn_unit<64, true>(lds, proj + (r0 + 256 * qb) * NPROJ + h * 64, NPROJ, proj + r0 * NPROJ + 512 + h * 64, proj + r0 * NPROJ + 1024 + h * 64, NPROJ,
                                    4 * qb + 4, 256 * qb, p.in[4], 0.125f * LOG2E, (const float*)(ws + WS_CK) + (size_t)bh * SEQ,
                                    (bf16*)(ws + WS_BUFA) + (r0 + 256 * qb) * DM + h * 64, DM, p.in[7]);
            }
        }
        SEAM(3);
    }
    if (IN(4)) {
        pg8::Gemm g{(const pb*)(ws + WS_BUFA), (const pb*)(ws + WS_WOUT), NT, DM, DM}; pg8::StaticOrder S; S.init(NT, DM, G, (int)blockIdx.x);
        pg8::EpiRes E{p.in[0], p.out, (pb*)(ws + WS_XB1), (float*)(ws + WS_SSQ1)};
        pg8::gemm_phase<pg8::EpiRes, pg8::StaticOrder, true, true>(lds, g, S, E);
        SEAM(4);
    }
    if (IN(5)) {
        pg8::Gemm g{(const pb*)(ws + WS_XB1), (const pb*)(ws + WS_WCQ), NT, 512, DM}; pg8::StaticOrder S; S.init(NT, 512, G, (int)blockIdx.x);
        pg8::EpiStore<0, true> E{(pb*)(ws + WS_CQ), 512, (const float*)(ws + WS_SSQ1)};
        pg8::gemm_phase<pg8::EpiStore<0, true>, pg8::StaticOrder, true, true>(lds, g, S, E);
        SEAM(5);
    }
    if (IN(6)) {
        for (int u = blockIdx.x; u < 512; u += G) {
            const int qb = u & 7, bh = u >> 3, b = bh >> 2, h = bh & 3;
            const bf16* cq = (const bf16*)(ws + WS_CQ); const bf16* ckv = (const bf16*)(ws + WS_CKV);
            const size_t r0 = (size_t)b * SEQ + 256 * qb;
            attn_unit<128, false>(lds, cq + r0 * 512 + h * 128, 512, ckv + (size_t)b * 256 * 1024 + h * 128, ckv + (size_t)b * 256 * 1024 + 512 + h * 128, 1024,
                                  4, 0, p.in[17], 0.08838834764831845f * LOG2E, nullptr, (bf16*)(ws + WS_CO) + r0 * 512 + h * 128, 512, nullptr);
        }
        SEAM(6);
    }
    if (IN(7)) {
        pg8::Gemm g{(const pb*)(ws + WS_CO), (const pb*)(ws + WS_WCO), NT, DM, 512}; pg8::StaticOrder S; S.init(NT, DM, G, (int)blockIdx.x);
        pg8::EpiRes E{p.out, p.out, (pb*)(ws + WS_BUFA), (float*)(ws + WS_SSQ2)};
        pg8::gemm_phase<pg8::EpiRes, pg8::StaticOrder, true, true>(lds, g, S, E);
        SEAM(7);
    }
    if (IN(8)) {
        pg8::Gemm g{(const pb*)(ws + WS_BUFA), (const pb*)(ws + WS_W1), NT, DFF, DM}; pg8::StaticOrder S; S.init(NT, DFF, G, (int)blockIdx.x);
        pg8::EpiStore<2, true> E{(pb*)(ws + WS_HMID), DFF, (const float*)(ws + WS_SSQ2)};
        pg8::gemm_phase<pg8::EpiStore<2, true>, pg8::StaticOrder, true, true>(lds, g, S, E);
        SEAM(8);
    }
    if (IN(9)) {
        pg8::Gemm g{(const pb*)(ws + WS_HMID), (const pb*)(ws + WS_W2), NT, DM, DFF}; pg8::StaticOrder S; S.init(NT, DM, G, (int)blockIdx.x);
        pg8::EpiRes E{p.out, p.out, nullptr, nullptr};
        pg8::gemm_phase<pg8::EpiRes, pg8::StaticOrder, true, true>(lds, g, S, E);
    }
#ifdef DBG_DUMP
    if (hi == NPH + 1 || lo == NPH) {
        const bf16* src = (const bf16*)(ws + (size_t)DBG_DUMP);
        for (size_t i = (size_t)blockIdx.x * 512 + tid; i < (size_t)NT * DM; i += (size_t)G * 512) p.out[i] = __uint_as_float((unsigned)src[i] << 16);
    }
#endif
#undef IN
#undef SEAM
}

extern "C" void kernel_launch(void* const* d_in, const int* in_sizes, int n_in, void* d_out, int out_size, void* d_ws, size_t ws_size, hipStream_t stream) {
    static int grid = 0;
    if (grid == 0) {
        if (n_in != 23 || out_size != NT * DM || ws_size < WS_END) { fprintf(stderr, "kernel_launch: unexpected shapes (n_in %d out %d ws %zu)\n", n_in, out_size, ws_size); grid = -1; return; }
        int dev = 0, cus = 0, per_cu = 0;
        (void)hipGetDevice(&dev); (void)hipDeviceGetAttribute(&cus, hipDeviceAttributeMultiprocessorCount, dev);
        if (hipFuncSetAttribute((const void*)fwd, hipFuncAttributeMaxDynamicSharedMemorySize, LDS_BYTES) != hipSuccess) { fprintf(stderr, "kernel_launch: hipFuncSetAttribute failed\n"); grid = -1; return; }
        if (hipOccupancyMaxActiveBlocksPerMultiprocessor(&per_cu, (const void*)fwd, 512, LDS_BYTES) != hipSuccess || per_cu < 1) { fprintf(stderr, "kernel_launch: occupancy query says %d\n", per_cu); per_cu = 1; }
        (void)hipGetLastError();
        grid = cus * (per_cu < 1 ? 1 : 1);
        if (grid <= 0) grid = 256;
    }
    if (grid < 0) return;
    Args a{};
    for (int i = 0; i < 23; ++i) a.p.in[i] = (const float*)d_in[i];
    a.p.out = (float*)d_out; a.p.ws = (unsigned char*)d_ws;
#if MK_MULTI
#ifdef DBG_DUMP
    for (int k = 0; k <= DBG_LAST; ++k) { a.ph_lo = k; a.ph_hi = k + 1; hipLaunchKernelGGL(fwd, dim3(grid), dim3(512), LDS_BYTES, stream, a); }
    a.ph_lo = NPH; a.ph_hi = NPH + 1; hipLaunchKernelGGL(fwd, dim3(grid), dim3(512), LDS_BYTES, stream, a);
#else
    for (int k = 0; k < NPH; ++k) { a.ph_lo = k; a.ph_hi = k + 1; hipLaunchKernelGGL(fwd, dim3(grid), dim3(512), LDS_BYTES, stream, a); }
#endif
#else
    a.ph_lo = 0; a.ph_hi = NPH;
    void* args[] = {&a};
    hipError_t e = hipLaunchCooperativeKernel((const void*)fwd, dim3(grid), dim3(512), args, LDS_BYTES, stream);
    if (e != hipSuccess) fprintf(stderr, "cooperative launch failed: %s (grid %d)\n", hipGetErrorString(e), grid);
#endif
}
```

```cpp
#include <hip/hip_runtime.h>
#include <hip/hip_cooperative_groups.h>
#include <cstdio>
#include <cstdint>
namespace cg = cooperative_groups;
#ifndef MK_MULTI
#define MK_MULTI 0
#endif
namespace pg8 {
#define PG8_LAS __attribute__((address_space(3)))
typedef unsigned short bf16_t;
typedef short bf16x8 __attribute__((ext_vector_type(8)));
typedef float f32x4 __attribute__((ext_vector_type(4)));
typedef unsigned u32x4 __attribute__((ext_vector_type(4)));
constexpr int BM = 256, BK = 64, HALF = 128, HTB = HALF * BK * 2  , STAGE_BYTES = 8 * HTB, NXCD = 8, WGM = 8;

__host__ __device__ __forceinline__ int lds_byte(int r, int c) { const int st = (r >> 4) * 2 + (c >> 5), rr = r & 15, cc = c & 31, ob = rr * 64 + cc * 2; return st * 1024 + (ob ^ (((ob >> 9) & 1) << 5)); }
__host__ __device__ __forceinline__ void stage_rc(int b, int& R, int& C) { const int st = b / 1024, sb = b % 1024, swz = sb ^ (((sb >> 9) & 1) << 5); R = (st >> 1) * 16 + swz / 64; C = (st & 1) * 32 + (swz % 64) / 2; }
__host__ __device__ __forceinline__ int perm32(int rho) { const int n = rho >> 4, i = rho & 15; return 8 * (i >> 2) + 4 * n + (i & 3); }

struct Unit { int pm, pn; };
struct Gemm { const bf16_t* A; const bf16_t* Bt; int M, N, K; };

struct StaticOrder {
    int nM, nN, nwg, G, c;
    __host__ __device__ void init(int M, int N, int G_, int c_) { nM = M / BM; nN = N / BM; nwg = nM * nN; G = G_; c = c_; }
    __host__ __device__ bool next(int i, Unit& u) const {
        const long L = (long)i * G + c; if (L >= nwg) return false;
        int wgid = (int)L; { const int q = nwg / NXCD, r = nwg % NXCD, xcd = wgid % NXCD, off = wgid / NXCD; wgid = (xcd < r ? xcd * (q + 1) : r * (q + 1) + (xcd - r) * q) + off; }
        const int nig = WGM * nN, gid = wgid / nig, fm = gid * WGM, gsz = (nM - fm) < WGM ? (nM - fm) : WGM;
        u.pm = fm + ((wgid % nig) % gsz); u.pn = (wgid % nig) / gsz; return true;
    }
    __device__ __forceinline__ void a_ready(const Unit&) const {}
    __device__ __forceinline__ void done(const Unit&) const {}
};
struct OneUnit {
    int pm, pn;
    __host__ __device__ bool next(int i, Unit& u) const { if (i != 0) return false; u.pm = pm; u.pn = pn; return true; }
    __device__ __forceinline__ void a_ready(const Unit&) const {}
    __device__ __forceinline__ void done(const Unit&) const {}
};
__device__ __forceinline__ unsigned cvt_pk_bf16(float lo, float hi) { unsigned r; asm volatile("v_cvt_pk_bf16_f32 %0, %1, %2" : "=v"(r) : "v"(lo), "v"(hi)); return r; }
template <int ACT, bool RS> struct EpiStore {
    static constexpr bool PERM = true, AFTER_DRAIN = false;
    bf16_t* O; int ldc; const float* ssq;
    __device__ __forceinline__ void pre(float (&rsv)[8], const Unit& u, int wr, int fr) const {
        if (RS) {
#pragma unroll
            for (int ai = 0; ai < 2; ++ai)
#pragma unroll
                for (int m = 0; m < 4; ++m) rsv[ai * 4 + m] = ssq[u.pm * BM + wr * 64 + fr + ai * HALF + m * 16];
        }
    }
    __device__ __forceinline__ void operator()(const f32x4 (&acc)[2][2][4][2], const float (&rsv)[8], const Unit& u, int wr, int wc, int fr, int fq) const {
        const int row0 = u.pm * BM + wr * 64 + fr, col0 = u.pn * BM + wc * 32 + 8 * fq;
#pragma unroll
        for (int ai = 0; ai < 2; ++ai)
#pragma unroll
            for (int m = 0; m < 4; ++m) {
                const int row = row0 + ai * HALF + m * 16;
                float rs = 1.f; if (RS) rs = rsqrtf(rsv[ai * 4 + m] * (1.0f / 1024.0f) + 1e-6f);
                bf16_t* rowp = O + (size_t)row * ldc + col0;
#pragma unroll
                for (int bj = 0; bj < 2; ++bj) {
                    f32x4 v0 = acc[ai][bj][m][0] * rs, v1 = acc[ai][bj][m][1] * rs;
                    if (ACT == 2) {
#pragma unroll
                        for (int e = 0; e < 4; ++e) { float a = fmaxf(v0[e], 0.f), b = fmaxf(v1[e], 0.f); v0[e] = a * a; v1[e] = b * b; }
                    }
                    u32x4 w; w.x = cvt_pk_bf16(v0[0], v0[1]); w.y = cvt_pk_bf16(v0[2], v0[3]); w.z = cvt_pk_bf16(v1[0], v1[1]); w.w = cvt_pk_bf16(v1[2], v1[3]);
                    *(u32x4*)(rowp + bj * HALF) = w;
                }
            }
    }
};
template <bool BASE_BF16, bool OUT_F32> struct EpiRes {
    static constexpr bool PERM = true, AFTER_DRAIN = false;
    const void* base; float* out; bf16_t* xb; float* ssq;
    __device__ __forceinline__ void pre(float (&rsv)[8], const Unit&, int, int) const {}
    __device__ __forceinline__ void operator()(const f32x4 (&acc)[2][2][4][2], const float (&rsv)[8], const Unit& u, int wr, int wc, int fr, int fq) const {
        const int row0 = u.pm * BM + wr * 64 + fr, col0 = u.pn * BM + wc * 32 + 8 * fq;
#pragma unroll
        for (int ai = 0; ai < 2; ++ai)
#pragma unroll
            for (int m = 0; m < 4; ++m) {
                const int row = row0 + ai * HALF + m * 16; float s = 0.f;
#pragma unroll
                for (int bj = 0; bj < 2; ++bj) {
                    const size_t off = (size_t)row * 1024 + col0 + bj * HALF;
                    f32x4 b0, b1;
                    if (BASE_BF16) { const u32x4 r = *(const u32x4*)((const bf16_t*)base + off);
                        b0 = (f32x4){__uint_as_float(r.x << 16), __uint_as_float(r.x & 0xffff0000u), __uint_as_float(r.y << 16), __uint_as_float(r.y & 0xffff0000u)};
                        b1 = (f32x4){__uint_as_float(r.z << 16), __uint_as_float(r.z & 0xffff0000u), __uint_as_float(r.w << 16), __uint_as_float(r.w & 0xffff0000u)}; }
                    else { b0 = *(const f32x4*)((const float*)base + off); b1 = *(const f32x4*)((const float*)base + off + 4); }
                    const f32x4 v0 = acc[ai][bj][m][0] + b0, v1 = acc[ai][bj][m][1] + b1;
                    if (OUT_F32) { *(f32x4*)(out + off) = v0; *(f32x4*)(out + off + 4) = v1; }
                    else {
                        u32x4 w; w.x = cvt_pk_bf16(v0[0], v0[1]); w.y = cvt_pk_bf16(v0[2], v0[3]); w.z = cvt_pk_bf16(v1[0], v1[1]); w.w = cvt_pk_bf16(v1[2], v1[3]); *(u32x4*)(xb + off) = w;
                        s += (v0[0] * v0[0] + v0[1] * v0[1]) + (v0[2] * v0[2] + v0[3] * v0[3]) + (v1[0] * v1[0] + v1[1] * v1[1]) + (v1[2] * v1[2] + v1[3] * v1[3]);
                    }
                }
                if (!OUT_F32) { s += __shfl_xor(s, 16); s += __shfl_xor(s, 32); if (fq == 0) atomicAdd(ssq + row, s); }
            }
    }
};

template <class Epi, class Sched, bool ALIGN_EPI = false, bool SP2 = false>
__device__ __forceinline__ void gemm_phase(PG8_LAS unsigned char* lds, const Gemm g, const Sched& S, const Epi& E) {
    const int tid = threadIdx.x, wid = __builtin_amdgcn_readfirstlane(tid >> 6), lane = tid & 63, wr = wid >> 2, wc = wid & 3, fr = lane & 15, fq = lane >> 4;
    const int K = g.K, nt = K / BK;
    unsigned voffA[2], voffB[2];
#pragma unroll
    for (int i = 0; i < 2; ++i) { int R, C; stage_rc(tid * 16 + i * 8192, R, C); const int Rb = Epi::PERM ? ((R & ~31) + perm32(R & 31)) : R;
        voffA[i] = (unsigned)(R * K + C) * 2u; voffB[i] = (unsigned)(Rb * K + C) * 2u; }
    const size_t kstep = (size_t)(BK * 2);
    const size_t hstep = (size_t)HALF * K * 2;
    const size_t tstep = 2 * hstep;
    const unsigned ldsw = (unsigned)wid * 1024u;
    const int aoff = lds_byte(wr * 64 + fr, fq * 8), boff = lds_byte(wc * 32 + fr, fq * 8);
#define PG8_SA(b, h) (((b) * 2 + (h)) * HTB)
#define PG8_SB(b, h) ((4 + (b) * 2 + (h)) * HTB)
#define PG8_STAGE(bufoff, gbase, voff) do { _Pragma("unroll") for (int _i = 0; _i < 2; ++_i) \
        __builtin_amdgcn_global_load_lds((const unsigned*)((const char*)(gbase) + (voff)[_i]), (PG8_LAS unsigned*)(lds + (bufoff) + ldsw + _i * 8192), 16, 0, 0); } while (0)
#define PG8_LDA(dst, b, h) do { _Pragma("unroll") for (int m = 0; m < 4; ++m) _Pragma("unroll") for (int k = 0; k < 2; ++k) dst[m][k] = *(const PG8_LAS bf16x8*)(lds + PG8_SA(b, h) + aoff + m * 2048 + k * 1024); } while (0)
#define PG8_LDB(dst, b, h) do { _Pragma("unroll") for (int n = 0; n < 2; ++n) _Pragma("unroll") for (int k = 0; k < 2; ++k) dst[n][k] = *(const PG8_LAS bf16x8*)(lds + PG8_SB(b, h) + boff + n * 2048 + k * 1024); } while (0)
#define PG8_MMA(ai, bj, At, Bt) do { __builtin_amdgcn_s_setprio(1); _Pragma("unroll") for (int m = 0; m < 4; ++m) _Pragma("unroll") for (int n = 0; n < 2; ++n) _Pragma("unroll") for (int k = 0; k < 2; ++k) \
        acc[ai][bj][m][n] = __builtin_amdgcn_mfma_f32_16x16x32_bf16(Bt[n][k], At[m][k], acc[ai][bj][m][n], 0, 0, 0); __builtin_amdgcn_s_setprio(0); } while (0)
#define PG8_WAIT_V(n) asm volatile("s_waitcnt vmcnt(" #n ")" ::: "memory")
#define PG8_WAIT_L(n) asm volatile("s_waitcnt lgkmcnt(" #n ")" ::: "memory")
#define PG8_BAR __builtin_amdgcn_s_barrier()
#define PG8_SCHED __builtin_amdgcn_sched_barrier(0)
    Unit cur, nxt; int ui = 0;
    if (!S.next(0, cur)) return;
    f32x4 acc[2][2][4][2];
#pragma unroll
    for (int a = 0; a < 2; ++a)
#pragma unroll
        for (int b = 0; b < 2; ++b)
#pragma unroll
            for (int m = 0; m < 4; ++m)
#pragma unroll
                for (int n = 0; n < 2; ++n) acc[a][b][m][n] = (f32x4){0.f, 0.f, 0.f, 0.f};
    bf16x8 At[4][2], B0[2][2], B1[2][2];
    const char* cA = (const char*)g.A + (size_t)cur.pm * tstep; const char* cB = (const char*)g.Bt + (size_t)cur.pn * tstep;
    S.a_ready(cur);
    if constexpr (SP2) {
        PG8_STAGE(PG8_SB(0, 0), cB, voffB); PG8_STAGE(PG8_SB(0, 1), cB + hstep, voffB); PG8_STAGE(PG8_SA(0, 0), cA, voffA); PG8_STAGE(PG8_SA(0, 1), cA + hstep, voffA);
        if (wr == 1) PG8_BAR;
        PG8_WAIT_V(2); PG8_BAR;
        PG8_STAGE(PG8_SB(1, 0), cB + kstep, voffB); PG8_STAGE(PG8_SA(1, 0), cA + kstep, voffA); PG8_STAGE(PG8_SB(1, 1), cB + hstep + kstep, voffB);
        PG8_WAIT_V(6); PG8_BAR;
    } else {
        PG8_STAGE(PG8_SB(0, 0), cB, voffB); PG8_STAGE(PG8_SA(0, 0), cA, voffA); PG8_STAGE(PG8_SB(0, 1), cB + hstep, voffB); PG8_STAGE(PG8_SA(0, 1), cA + hstep, voffA);
        if (wr == 1) PG8_BAR;
        PG8_WAIT_V(4); PG8_BAR;
        PG8_STAGE(PG8_SB(1, 0), cB + kstep, voffB); PG8_STAGE(PG8_SA(1, 0), cA + kstep, voffA); PG8_STAGE(PG8_SB(1, 1), cB + hstep + kstep, voffB);
        PG8_WAIT_V(6); PG8_BAR;
    }
    float rsv[8];
    for (;;) {
        const bool has_next = S.next(ui + 1, nxt);
        E.pre(rsv, cur, wr, fr);
        const char* nA = has_next ? (const char*)g.A + (size_t)nxt.pm * tstep : cA; const char* nB = has_next ? (const char*)g.Bt + (size_t)nxt.pn * tstep : cB;
        for (int t = 0; t < nt; t += 2) {
            const bool last = (t == nt - 2);
            const char* a1 = cA + (size_t)(t + 1) * kstep;
            const char* a2 = last ? nA : cA + (size_t)(t + 2) * kstep; const char* b2 = last ? nB : cB + (size_t)(t + 2) * kstep;
            const char* a3 = a2 + kstep; const char* b3 = b2 + kstep;
            if (last && has_next) S.a_ready(nxt);
            if constexpr (SP2) {
            PG8_LDB(B0, 0, 0); PG8_LDB(B1, 0, 1); PG8_SCHED; PG8_LDA(At, 0, 0); PG8_STAGE(PG8_SA(1, 1), a1 + hstep, voffA);
            PG8_WAIT_V(8); PG8_WAIT_L(0); PG8_BAR; PG8_MMA(0, 0, At, B0); PG8_MMA(0, 1, At, B1); PG8_BAR; PG8_SCHED;
            PG8_LDA(At, 0, 1); PG8_STAGE(PG8_SB(0, 0), b2, voffB); PG8_STAGE(PG8_SB(0, 1), b2 + hstep, voffB); PG8_STAGE(PG8_SA(0, 0), a2, voffA);
            PG8_WAIT_V(8); PG8_WAIT_L(0); PG8_BAR; PG8_MMA(1, 0, At, B0); PG8_MMA(1, 1, At, B1); PG8_BAR; PG8_SCHED;
            PG8_LDB(B0, 1, 0); PG8_LDB(B1, 1, 1); PG8_SCHED; PG8_LDA(At, 1, 0); PG8_STAGE(PG8_SA(0, 1), a2 + hstep, voffA);
            PG8_WAIT_V(8); PG8_WAIT_L(0); PG8_BAR; PG8_MMA(0, 0, At, B0); PG8_MMA(0, 1, At, B1); PG8_BAR; PG8_SCHED;
            PG8_LDA(At, 1, 1); PG8_STAGE(PG8_SB(1, 0), b3, voffB); PG8_STAGE(PG8_SB(1, 1), b3 + hstep, voffB); PG8_STAGE(PG8_SA(1, 0), a3, voffA);
            PG8_WAIT_V(8); PG8_WAIT_L(0); PG8_BAR; PG8_MMA(1, 0, At, B0); PG8_MMA(1, 1, At, B1); PG8_BAR; PG8_SCHED;
            } else {
            PG8_LDB(B0, 0, 0); PG8_SCHED; PG8_LDA(At, 0, 0); PG8_STAGE(PG8_SA(1, 1), a1 + hstep, voffA);
            PG8_WAIT_L(8); PG8_BAR; PG8_WAIT_L(0); PG8_MMA(0, 0, At, B0); PG8_BAR; PG8_SCHED;
            PG8_LDB(B1, 0, 1); PG8_STAGE(PG8_SB(0, 0), b2, voffB);
            PG8_BAR; PG8_WAIT_L(0); PG8_MMA(0, 1, At, B1); PG8_BAR;
            PG8_LDA(At, 0, 1); PG8_STAGE(PG8_SA(0, 0), a2, voffA);
            PG8_BAR; PG8_WAIT_L(0); PG8_MMA(1, 0, At, B0); PG8_BAR; PG8_SCHED;
            PG8_STAGE(PG8_SB(0, 1), b2 + hstep, voffB);
            PG8_WAIT_V(6); PG8_BAR; PG8_MMA(1, 1, At, B1); PG8_BAR;
            PG8_LDB(B0, 1, 0); PG8_SCHED; PG8_LDA(At, 1, 0); PG8_STAGE(PG8_SA(0, 1), a2 + hstep, voffA);
            PG8_WAIT_L(8); PG8_BAR; PG8_WAIT_L(0); PG8_MMA(0, 0, At, B0); PG8_BAR; PG8_SCHED;
            PG8_LDB(B1, 1, 1); PG8_STAGE(PG8_SB(1, 0), b3, voffB);
            PG8_BAR; PG8_WAIT_L(0); PG8_MMA(0, 1, At, B1); PG8_BAR;
            PG8_LDA(At, 1, 1); PG8_STAGE(PG8_SA(1, 0), a3, voffA);
            PG8_BAR; PG8_WAIT_L(0); PG8_MMA(1, 0, At, B0); PG8_BAR; PG8_SCHED;
            PG8_STAGE(PG8_SB(1, 1), b3 + hstep, voffB);
            PG8_WAIT_V(6); PG8_BAR; PG8_MMA(1, 1, At, B1); PG8_BAR;
            }
        }
        if constexpr (ALIGN_EPI) { if (wr == 0) PG8_BAR; }
        if constexpr (!Epi::AFTER_DRAIN) { E(acc, rsv, cur, wr, wc, fr, fq); S.done(cur); }
        if (!has_next) break;
#pragma unroll
        for (int a = 0; a < 2; ++a)
#pragma unroll
            for (int b = 0; b < 2; ++b)
#pragma unroll
                for (int m = 0; m < 4; ++m)
#pragma unroll
                    for (int n = 0; n < 2; ++n) acc[a][b][m][n] = (f32x4){0.f, 0.f, 0.f, 0.f};
        cur = nxt; cA = nA; cB = nB; ++ui;
        if constexpr (ALIGN_EPI) { if (wr == 1) PG8_BAR; }
    }
    PG8_WAIT_V(0);
    if constexpr (!ALIGN_EPI) { if (wr == 0) PG8_BAR; }
    PG8_BAR;
    if constexpr (Epi::AFTER_DRAIN) { E.fused(acc, cur, wr, wc, fr, fq, lds, wid, lane); S.done(cur); }
#undef PG8_SA
#undef PG8_SB
#undef PG8_STAGE
#undef PG8_LDA
#undef PG8_LDB
#undef PG8_MMA
#undef PG8_WAIT_V
#undef PG8_WAIT_L
#undef PG8_BAR
#undef PG8_SCHED
}
}
#define LAS __attribute__((address_space(3)))
typedef unsigned short bf16;
typedef short bf16x8 __attribute__((ext_vector_type(8)));
typedef short s16x4 __attribute__((ext_vector_type(4)));
typedef float f32x4 __attribute__((ext_vector_type(4)));
typedef float f32x16 __attribute__((ext_vector_type(16)));
typedef unsigned u32x4 __attribute__((ext_vector_type(4)));
typedef unsigned u32x2 __attribute__((ext_vector_type(2)));
typedef LAS unsigned char* lptr;
constexpr int NT = 32768, DM = 1024, SEQ = 2048, NB = 16, NPROJ = 3584, DFF = 4096, MEMR = 4096;
constexpr float EPS = 1e-6f, LOG2E = 1.4426950408889634f;
constexpr size_t MiB = 1u << 20;
constexpr size_t WS_CTL = 0, WS_BARW = 16384, WS_SSQ1 = 1 * MiB, WS_SSQ2 = 1 * MiB + 131072, WS_GATES = 2 * MiB, WS_CK = 4 * MiB, WS_GL = 5 * MiB;
constexpr size_t WS_WIN = 6 * MiB, WS_WOUT = 13 * MiB, WS_WCQ = 15 * MiB, WS_WCKV = 16 * MiB, WS_WCO = 18 * MiB, WS_W1 = 19 * MiB, WS_W2 = 27 * MiB;
constexpr size_t WS_HM = 35 * MiB, WS_CKV = 43 * MiB, WS_BUFA = 52 * MiB, WS_BIG = 116 * MiB;
constexpr size_t WS_PROJ = WS_BIG, WS_GP = WS_BIG + 224 * MiB, WS_XB1 = WS_BIG, WS_CQ = WS_BIG + 64 * MiB, WS_CO = WS_BIG + 96 * MiB, WS_HMID = WS_BIG;
constexpr size_t WS_END = WS_GP + 144 * MiB;
constexpr int GP_CHUNK = 73728, GP_W = 0, GP_QG = 16384, GP_KDT = 32768, GP_UT = 49152, GP_IN = 65536;
constexpr int LDS_BYTES = 147456, LDS_MISC = LDS_BYTES - 64;
constexpr int NPH = 10;

__device__ __forceinline__ float bflo(unsigned u) { return __uint_as_float(u << 16); }
__device__ __forceinline__ float bfhi(unsigned u) { return __uint_as_float(u & 0xffff0000u); }
typedef float f32x2_t __attribute__((ext_vector_type(2))); typedef __bf16 bf16x2_t __attribute__((ext_vector_type(2)));
__device__ __forceinline__ unsigned pk2(float lo, float hi) { f32x2_t v = {lo, hi}; bf16x2_t b = __builtin_convertvector(v, bf16x2_t); return __builtin_bit_cast(unsigned, b); }
__device__ __forceinline__ unsigned pk2v(float lo, float hi) { return pg8::cvt_pk_bf16(lo, hi); }
__device__ __forceinline__ f32x4 mfma16(bf16x8 a, bf16x8 b, f32x4 c) { return __builtin_amdgcn_mfma_f32_16x16x32_bf16(a, b, c, 0, 0, 0); }
__device__ __forceinline__ f32x16 mfma32(bf16x8 a, bf16x8 b, f32x16 c) { return __builtin_amdgcn_mfma_f32_32x32x16_bf16(a, b, c, 0, 0, 0); }
__device__ __forceinline__ bf16x8 lds8(lptr p) { return *(const LAS bf16x8*)p; }
typedef short v4i16_t __attribute__((ext_vector_type(4)));
__device__ __forceinline__ s16x4 vtr(lptr pv) { return __builtin_bit_cast(s16x4, __builtin_amdgcn_ds_read_tr16_b64_v4i16((LAS v4i16_t*)pv)); }
template <int CTRL> __device__ __forceinline__ float dpp_add(float v) { const int t = __builtin_amdgcn_update_dpp(0, __builtin_bit_cast(int, v), CTRL, 0xf, 0xf, true); return v + __builtin_bit_cast(float, t); }
__device__ __forceinline__ float row8_sum(float v) { v = dpp_add<0xB1>(v); v = dpp_add<0x4E>(v); v = dpp_add<0x141>(v); return v; }
__device__ __forceinline__ float row16_sum(float v) { v = row8_sum(v); v = dpp_add<0x140>(v); return v; }
__device__ __forceinline__ float rdl(float v, int l) { return __builtin_bit_cast(float, __builtin_amdgcn_readlane(__builtin_bit_cast(int, v), l)); }
__device__ __forceinline__ float wave_sum(float v) { v = row16_sum(v); return (rdl(v, 0) + rdl(v, 16)) + (rdl(v, 32) + rdl(v, 48)); }
__device__ __forceinline__ float xor32(float v) { const auto r = __builtin_amdgcn_permlane32_swap(__float_as_uint(v), __float_as_uint(v), false, false); return (threadIdx.x & 32) ? __uint_as_float(r[0]) : __uint_as_float(r[1]); }
#define LDS_WAIT() asm volatile("s_waitcnt lgkmcnt(0)" ::: "memory")
__device__ __forceinline__ float siluf(float y) { return y * __builtin_amdgcn_rcpf(1.f + __expf(-y)); }
__device__ __forceinline__ float softplusf(float z) { return fmaxf(z, 0.f) + log1pf(__expf(-fabsf(z))); }

__device__ __forceinline__ void transpose_item(const float* W, int K, int Ntot, int col0, int ncols, bf16* WT, int row_off, const float* gain, LAS float* scr, int item, int lane) {
    const int nblk = ncols / 32, kb = item / nblk, nb = item % nblk, k0 = 64 * kb, n0 = 32 * nb;
#pragma unroll
    for (int i = 0; i < 32; ++i) { const int kk = 2 * i + (lane >> 5); float v = W[(size_t)(k0 + kk) * Ntot + col0 + n0 + (lane & 31)]; if (gain) v *= gain[k0 + kk]; scr[kk * 33 + (lane & 31)] = v; }
    LDS_WAIT();
    const int c = lane & 7;
#pragma unroll
    for (int j = 0; j < 4; ++j) { const int n = (lane >> 3) + 8 * j; const LAS float* s = scr + (8 * c) * 33 + n;
        u32x4 o; o.x = pk2v(s[0 * 33], s[1 * 33]); o.y = pk2v(s[2 * 33], s[3 * 33]); o.z = pk2v(s[4 * 33], s[5 * 33]); o.w = pk2v(s[6 * 33], s[7 * 33]);
        *(u32x4*)(WT + (size_t)(row_off + n0 + n) * K + k0 + 8 * c) = o; }
    LDS_WAIT();
}
struct P { const float* in[23]; float* out; unsigned char* ws; };

template <bool GATES>
__device__ __forceinline__ void norm_row(const P& p, f32x4 (&v)[4], const float* g, bf16* orow, float* gates_row, const LAS float* w16, int lane) {
    const f32x4* gr = (const f32x4*)g + lane;
    float s = 0.f;
#pragma unroll
    for (int j = 0; j < 4; ++j) { s += (v[j].x * v[j].x + v[j].y * v[j].y) + (v[j].z * v[j].z + v[j].w * v[j].w); }
    const float rstd = rsqrtf(wave_sum(s) * (1.f / DM) + EPS);
    unsigned long long* o8 = (unsigned long long*)orow + lane;
#pragma unroll
    for (int j = 0; j < 4; ++j) { v[j] = v[j] * rstd * gr[64 * j]; o8[64 * j] = (unsigned long long)pk2v(v[j].x, v[j].y) | ((unsigned long long)pk2v(v[j].z, v[j].w) << 32); }
    if (GATES) {
        float mine = 0.f;
#pragma unroll
        for (int c4 = 0; c4 < 4; ++c4) {
            f32x4 w4[4][4];
#pragma unroll
            for (int cc = 0; cc < 4; ++cc)
#pragma unroll
                for (int j = 0; j < 4; ++j) w4[cc][j] = *(const LAS f32x4*)(w16 + (4 * c4 + cc) * 1024 + 256 * j + 4 * lane);
            __builtin_amdgcn_sched_barrier(0);
#pragma unroll
            for (int cc = 0; cc < 4; ++cc) {
                float d = 0.f;
#pragma unroll
                for (int j = 0; j < 4; ++j) d += (v[j].x * w4[cc][j].x + v[j].y * w4[cc][j].y) + (v[j].z * w4[cc][j].z + v[j].w * w4[cc][j].w);
                d = wave_sum(d);
                mine = (lane == 4 * c4 + cc) ? d : mine;
            }
        }
        if (lane < 16) {
            float r;
            if (lane < 8) { const float z = mine + p.in[6][lane]; r = -softplusf(-z); }
            else if (lane < 12) { r = 1.f / (1.f + __expf(-mine)); }
            else { r = -__expf(p.in[9][lane - 12]) * softplusf(mine + p.in[10][lane - 12]); }
            gates_row[lane] = r;
        }
    }
}

constexpr int LATE_ITEMS = 16 * 32 + 16 * 16 + 8 * 32 + 16 * 128 + 64 * 32;
__device__ __forceinline__ void late_transpose_item(const P& p, LAS float* scr, int r, int lane) {
    unsigned char* ws = p.ws;
    constexpr int I3 = 16 * 32, I4 = 16 * 16, I6 = 8 * 32, I7 = 16 * 128;
    if (r < I3) { transpose_item(p.in[12], 1024, 1024, 0, 1024, (bf16*)(ws + WS_WOUT), 0, nullptr, scr, r, lane); return; } r -= I3;
    if (r < I4) { transpose_item(p.in[15], 1024, 512, 0, 512, (bf16*)(ws + WS_WCQ), 0, p.in[13], scr, r, lane); return; } r -= I4;
    if (r < I6) { transpose_item(p.in[19], 512, 1024, 0, 1024, (bf16*)(ws + WS_WCO), 0, nullptr, scr, r, lane); return; } r -= I6;
    if (r < I7) { transpose_item(p.in[21], 1024, 4096, 0, 4096, (bf16*)(ws + WS_W1), 0, p.in[20], scr, r, lane); return; } r -= I7;
    transpose_item(p.in[22], 4096, 1024, 0, 1024, (bf16*)(ws + WS_W2), 0, nullptr, scr, r, lane);
}

__device__ __forceinline__ void p0_prologue(const P& p, lptr lds, int G) {
    const int tid = threadIdx.x, lane = tid & 63, wave = tid >> 6;
    const int gw = blockIdx.x * 8 + wave, NGW = G * 8;
    unsigned char* ws = p.ws;
    for (int i = blockIdx.x * 512 + tid; i < 2 * NT; i += G * 512) ((float*)(ws + WS_SSQ1))[i] = 0.f;
    if (blockIdx.x == 0 && tid < 64) ((unsigned*)(ws + WS_CTL))[tid] = 0u;
    LAS float* w16 = (LAS float*)lds;
    {
        float wv[32];
#pragma unroll
        for (int u = 0; u < 32; ++u) { const int i = tid + 512 * u, k = i >> 4, c = i & 15; const int col = c < 8 ? 1536 + c : 3072 + c; wv[u] = p.in[3][(size_t)k * 3600 + col]; }
#pragma unroll
        for (int u = 0; u < 32; ++u) { const int i = tid + 512 * u, k = i >> 4, c = i & 15; *(LAS bf16*)(lds + c * 2064 + k * 2) = (bf16)(pk2v(wv[u], 0.f) & 0xffffu); }
    }
    LAS float* scr = (LAS float*)(lds + 65536 + wave * 8448);
    constexpr int I0 = 16 * 48, I1 = 16 * 48, I2 = 16 * 16, I3 = 16 * 32, I4 = 16 * 16, I5 = 16 * 32, I6 = 8 * 32, I7 = 16 * 128, I8 = 64 * 32;
    constexpr int NITEMS = I0 + I1 + I2 + I3 + I4 + I5 + I6 + I7 + I8;
    for (int it = gw; it < I0 + I1 + I2 + I5; it += NGW) {
        int r = it;
        if (r < I0) { transpose_item(p.in[3], 1024, 3600, 0, 1536, (bf16*)(ws + WS_WIN), 0, nullptr, scr, r, lane); continue; } r -= I0;
        if (r < I1) { transpose_item(p.in[3], 1024, 3600, 1544, 1536, (bf16*)(ws + WS_WIN), 1536, nullptr, scr, r, lane); continue; } r -= I1;
        if (r < I2) { transpose_item(p.in[3], 1024, 3600, 3088, 512, (bf16*)(ws + WS_WIN), 3072, nullptr, scr, r, lane); continue; } r -= I2;
        transpose_item(p.in[16], 1024, 1024, 0, 1024, (bf16*)(ws + WS_WCKV), 0, nullptr, scr, r, lane);
    }
    __syncthreads();
    {
        const lptr tile = lds + 65536 + wave * 8448;
        const int fr = lane & 15, fg = lane >> 4;
        f32x4 gq[4];
#pragma unroll
        for (int j = 0; j < 4; ++j) gq[j] = ((const f32x4*)p.in[2] + lane)[64 * j];
        const int nrow = (NT - gw + NGW - 1) / NGW;
        const int gty = fr < 8 ? 0 : (fr < 12 ? 1 : 2);
        const float gadd = (gty == 0) ? p.in[6][fr & 7] : ((gty == 2) ? p.in[10][fr & 3] : 0.f);
        const float gA = -__expf(p.in[9][fr & 3]);
        f32x4 cur[4][4];
#pragma unroll
        for (int q = 0; q < 4; ++q) if (q < nrow) {
#pragma unroll
            for (int j = 0; j < 4; ++j) cur[q][j] = ((const f32x4*)(p.in[0] + (size_t)(gw + q * NGW) * DM) + lane)[64 * j];
        }
        for (int i0 = 0; i0 < nrow; i0 += 4) {
#pragma unroll
            for (int q = 0; q < 4; ++q) if (i0 + q < nrow) {
                const int m = gw + (i0 + q) * NGW;
                float ssum = 0.f;
#pragma unroll
                for (int j = 0; j < 4; ++j) ssum += (cur[q][j].x * cur[q][j].x + cur[q][j].y * cur[q][j].y) + (cur[q][j].z * cur[q][j].z + cur[q][j].w * cur[q][j].w);
                const float rstd = rsqrtf(wave_sum(ssum) * (1.f / DM) + EPS);
                unsigned long long* o8 = (unsigned long long*)((bf16*)(ws + WS_BUFA) + (size_t)m * DM) + lane;
#pragma unroll
                for (int j = 0; j < 4; ++j) { const f32x4 v = cur[q][j] * rstd * gq[j];
                    const unsigned long long w = (unsigned long long)pk2v(v.x, v.y) | ((unsigned long long)pk2v(v.z, v.w) << 32);
                    o8[64 * j] = w; *(LAS unsigned long long*)(tile + q * 2064 + (256 * j + 4 * lane) * 2) = w; }
            }
#pragma unroll
            for (int q = 0; q < 4; ++q) if (i0 + 4 + q < nrow) {
#pragma unroll
                for (int j = 0; j < 4; ++j) cur[q][j] = ((const f32x4*)(p.in[0] + (size_t)(gw + (i0 + 4 + q) * NGW) * DM) + lane)[64 * j];
            }
            LDS_WAIT();
            f32x4 acc = (f32x4){0.f, 0.f, 0.f, 0.f};
#pragma unroll
            for (int kb = 0; kb < 4; ++kb) {
                bf16x8 af[8], bfr[8];
#pragma unroll
                for (int k8 = 0; k8 < 8; ++k8) { const int kk = 8 * kb + k8; af[k8] = lds8(tile + (fr & 3) * 2064 + (32 * kk + 8 * fg) * 2); bfr[k8] = lds8(lds + fr * 2064 + (32 * kk + 8 * fg) * 2); }
                __builtin_amdgcn_sched_barrier(0);
#pragma unroll
                for (int k8 = 0; k8 < 8; ++k8) acc = mfma16(af[k8], bfr[k8], acc);
                __builtin_amdgcn_sched_barrier(0);
            }
            if (fg == 0) {
#pragma unroll
                for (int e = 0; e < 4; ++e) if (i0 + e < nrow) {
                    const float z = acc[e] + gadd, ex = __expf(-fabsf(z)), den = 1.f + ex, l = __logf(den), r = __builtin_amdgcn_rcpf(den);
                    const float spp = fmaxf(z, 0.f) + l, spn = fmaxf(-z, 0.f) + l, sg = (z >= 0.f) ? r : ex * r;
                    const float o = (gty == 0) ? -spn : ((gty == 1) ? sg : gA * spp);
                    ((float*)(ws + WS_GATES))[(size_t)(gw + (i0 + e) * NGW) * 16 + fr] = o;
                }
            }
            LDS_WAIT();
        }
        if (G != 256) {
#pragma unroll
        for (int q = 0; q < 4; ++q) if (gw + q * NGW < MEMR) {
#pragma unroll
            for (int j = 0; j < 4; ++j) cur[q][j] = ((const f32x4*)(p.in[1] + (size_t)(gw + q * NGW) * DM) + lane)[64 * j];
        }
#pragma unroll
        for (int q = 0; q < 4; ++q) if (gw + q * NGW < MEMR) norm_row<false>(p, cur[q], p.in[14], (bf16*)(ws + WS_HM) + (size_t)(gw + q * NGW) * DM, nullptr, w16, lane);
        for (int m = gw + 4 * NGW; m < MEMR; m += NGW) {
#pragma unroll
            for (int j = 0; j < 4; ++j) cur[0][j] = ((const f32x4*)(p.in[1] + (size_t)m * DM) + lane)[64 * j];
            norm_row<false>(p, cur[0], p.in[14], (bf16*)(ws + WS_HM) + (size_t)m * DM, nullptr, w16, lane);
        }
        }
    }
    __syncthreads();
}
constexpr int PQ_KN = 0, PQ_V = 17408, PQ_QS = 34816, PQ_TB = 34816, PQ_TW = 44032, PQ_LM = 53248, PQ_GC = 69632, PQ_BETA = 69888, PQ_STREAM = 70144;

template <int GLN>
__device__ __forceinline__ void knorm_rows8(bf16* base, size_t pitch, int m0, int mstride, int mend, const float* gain, int lane) {
    const float* gp = gain + (lane & (GLN - 1)) * 8;
    const f32x4 g0 = *(const f32x4*)gp, g1 = *(const f32x4*)(gp + 4);
    u32x4 raw[8];
#pragma unroll
    for (int u = 0; u < 8; ++u) { const int m = m0 + u * mstride; raw[u] = (u32x4){0u, 0u, 0u, 0u}; if (m < mend) raw[u] = *(const u32x4*)(base + (size_t)m * pitch + lane * 8); }
#pragma unroll
    for (int u = 0; u < 8; ++u) {
        const int m = m0 + u * mstride;
        float y[8] = {bflo(raw[u].x), bfhi(raw[u].x), bflo(raw[u].y), bfhi(raw[u].y), bflo(raw[u].z), bfhi(raw[u].z), bflo(raw[u].w), bfhi(raw[u].w)};
        float ss = 0.f;
#pragma unroll
        for (int e = 0; e < 8; ++e) ss += y[e] * y[e];
        ss = (GLN == 8) ? row8_sum(ss) : row16_sum(ss);
        const float rs = rsqrtf(ss * (1.f / (8 * GLN)) + EPS);
        u32x4 o; o.x = pk2(y[0] * rs * g0.x, y[1] * rs * g0.y); o.y = pk2(y[2] * rs * g0.z, y[3] * rs * g0.w); o.z = pk2(y[4] * rs * g1.x, y[5] * rs * g1.y); o.w = pk2(y[6] * rs * g1.z, y[7] * rs * g1.w);
        if (m < mend) *(u32x4*)(base + (size_t)m * pitch + lane * 8) = o;
    }
}

__device__ __forceinline__ void gdn_prep_pair(const P& p, lptr lds0, int pair, int kn_base, int kn_cnt) {
    int tid_ = threadIdx.x; asm volatile("" : "+v"(tid_));
    const int tid = tid_, lane = tid & 63, wave = __builtin_amdgcn_readfirstlane(tid >> 6), fr = lane & 15, fg = lane >> 4;
    const int st = wave >> 2, ws4 = wave & 3;
    const lptr lds = lds0 + st * PQ_STREAM;
    const int cid = 2 * pair + st;
    const int b = cid >> 7, h = (cid >> 5) & 3, n = cid & 31;
    const int R0 = b * SEQ + n * 64;
    unsigned char* ws = p.ws;
    const float* gates = (const float*)(ws + WS_GATES);
    const bf16* proj = (const bf16*)(ws + WS_PROJ);
    unsigned char* gp = ws + WS_GP + (size_t)cid * GP_CHUNK;
    float gcl = gates[(size_t)(R0 + lane) * 16 + 12 + h];
    const float betal = gates[(size_t)(R0 + lane) * 16 + 8 + h];
#pragma unroll
    for (int o = 1; o < 64; o <<= 1) { const float t = __shfl_up(gcl, o); if (lane >= o) gcl += t; }
    const float glast = rdl(gcl, 63);
    if (ws4 == 0) { ((LAS float*)(lds + PQ_GC))[lane] = gcl; ((LAS float*)(lds + PQ_BETA))[lane] = betal; if (lane == 0) ((float*)(ws + WS_GL))[cid] = __expf(glast); }
    if (lane < 48) {
        const int sec = lane >> 4, oc = lane & 15;
        const int pcol = 1536 + sec * 512 + h * 128 + oc * 8, cc = sec * 512 + h * 128 + oc * 8;
        u32x4 raw[19];
#pragma unroll
        for (int i = 0; i < 19; ++i) {
            const int ts = n * 64 + ws4 * 16 - 3 + i;
            raw[i] = (u32x4){0u, 0u, 0u, 0u};
            if (ts >= 0) raw[i] = *(const u32x4*)(proj + (size_t)(b * SEQ + ts) * NPROJ + pcol);
        }
        float cw[4][8];
#pragma unroll
        for (int j = 0; j < 4; ++j) { const f32x4 a = *(const f32x4*)(p.in[8] + j * 1536 + cc), c2 = *(const f32x4*)(p.in[8] + j * 1536 + cc + 4);
            cw[j][0] = a.x; cw[j][1] = a.y; cw[j][2] = a.z; cw[j][3] = a.w; cw[j][4] = c2.x; cw[j][5] = c2.y; cw[j][6] = c2.z; cw[j][7] = c2.w; }
#pragma unroll
        for (int rr = 0; rr < 16; ++rr) {
            const int r = ws4 * 16 + rr;
            float y[8]; float ss = 0.f;
#pragma unroll
            for (int ch = 0; ch < 8; ++ch) {
                float a = 0.f;
#pragma unroll
                for (int j = 0; j < 4; ++j) { const unsigned wd = raw[rr + j][ch >> 1]; a += cw[j][ch] * ((ch & 1) ? bfhi(wd) : bflo(wd)); }
                a = siluf(a); y[ch] = a; ss += a * a; }
            ss = row16_sum(ss);
            const float rn = rsqrtf(ss + EPS);
            const float gcr = rdl(gcl, r);
            const float s1 = (sec == 0) ? rn * 0.08838834764831845f : ((sec == 1) ? rn : 1.f);
            const float s2 = (sec == 0) ? s1 * __expf(gcr) : s1 * __expf(glast - gcr);
            u32x4 o; o.x = pk2(y[0] * s1, y[1] * s1); o.y = pk2(y[2] * s1, y[3] * s1); o.z = pk2(y[4] * s1, y[5] * s1); o.w = pk2(y[6] * s1, y[7] * s1);
            *(LAS u32x4*)(lds + ((sec == 0) ? PQ_QS : ((sec == 1) ? PQ_KN : PQ_V)) + r * 272 + oc * 16) = o;
            if (sec < 2) {
                u32x4 o2; o2.x = pk2(y[0] * s2, y[1] * s2); o2.y = pk2(y[2] * s2, y[3] * s2); o2.z = pk2(y[4] * s2, y[5] * s2); o2.w = pk2(y[6] * s2, y[7] * s2);
                *(u32x4*)(gp + ((sec == 0) ? GP_QG : GP_KDT) + r * 256 + oc * 16) = o2;
            }
        }
    }
    __syncthreads();
    {
        const LAS float* GC = (const LAS float*)(lds + PQ_GC); const LAS float* BT = (const LAS float*)(lds + PQ_BETA);
        const int ti = ws4;
#pragma unroll
        for (int tj = 0; tj < 4; ++tj) {
            if (tj <= ti) {
                f32x4 c = (f32x4){0.f, 0.f, 0.f, 0.f};
#pragma unroll
                for (int kk = 0; kk < 4; ++kk) c = mfma16(lds8(lds + PQ_KN + (16 * ti + fr) * 272 + (32 * kk + 8 * fg) * 2), lds8(lds + PQ_KN + (16 * tj + fr) * 272 + (32 * kk + 8 * fg) * 2), c);
                const int j = 16 * tj + fr; const float gj = GC[j];
#pragma unroll
                for (int e = 0; e < 4; ++e) { const int i = 16 * ti + 4 * fg + e; const float v = (i > j) ? BT[i] * c[e] * __expf(GC[i] - gj) : 0.f; ((LAS float*)(lds + PQ_LM))[i * 64 + j] = v; }
            }
            {
                const int i = 16 * ti + fr; u32x2 o = (u32x2){0u, 0u};
                if (tj <= ti) {
                    f32x4 c = (f32x4){0.f, 0.f, 0.f, 0.f};
#pragma unroll
                    for (int kk = 0; kk < 4; ++kk) c = mfma16(lds8(lds + PQ_KN + (16 * tj + fr) * 272 + (32 * kk + 8 * fg) * 2), lds8(lds + PQ_QS + (16 * ti + fr) * 272 + (32 * kk + 8 * fg) * 2), c);
                    const float gi = GC[i]; float v[4];
#pragma unroll
                    for (int e = 0; e < 4; ++e) { const int j = 16 * tj + 4 * fg + e; v[e] = (j <= i) ? c[e] * __expf(gi - GC[j]) : 0.f; }
                    o.x = pk2(v[0], v[1]); o.y = pk2(v[2], v[3]);
                }
                *(u32x2*)(gp + GP_IN + i * 128 + (16 * tj + 4 * fg) * 2) = o;
            }
        }
    }
    __syncthreads();
    if (ws4 != st) {
        const int j = (wave <= 4) ? wave - 1 : wave - 2;
        const int m0 = kn_base + 6 * j, mend = (m0 + 6 < kn_base + kn_cnt) ? m0 + 6 : kn_base + kn_cnt;
        if (m0 < mend) knorm_rows8<8>((bf16*)(ws + WS_PROJ) + 512, NPROJ, m0, 1, mend, p.in[5], lane);
        if (j == 5 && kn_cnt > 0) {
            const int hb = (kn_base >> 3);
            f32x4 mr[4][4];
#pragma unroll
            for (int q = 0; q < 4; ++q)
#pragma unroll
                for (int jj = 0; jj < 4; ++jj) mr[q][jj] = ((const f32x4*)(p.in[1] + (size_t)(hb + q) * DM) + lane)[64 * jj];
#pragma unroll
            for (int q = 0; q < 4; ++q) norm_row<false>(p, mr[q], p.in[14], (bf16*)(ws + WS_HM) + (size_t)(hb + q) * DM, nullptr, nullptr, lane);
        }
    }
    if (ws4 == st) {
        typedef float f32x2 __attribute__((ext_vector_type(2)));
        f32x2 tv[32];
#pragma unroll
        for (int q = 0; q < 32; ++q) tv[q] = (f32x2){0.f, 0.f};
        int vz; asm volatile("v_mov_b32 %0, 0" : "=v"(vz));
        const lptr lmb = lds + PQ_LM + vz;
        f32x4 pre[2][8], late[8];
        tv[0].x = (lane == 0) ? 1.f : 0.f;
        pre[1][0] = *(const LAS f32x4*)(lmb + (1 * 64) * 4);
#pragma unroll
        for (int i = 1; i < 64; ++i) {
#pragma unroll
            for (int q = 8; q < (i + 3) / 4; ++q) late[q - 8] = *(const LAS f32x4*)(lmb + (i * 64 + 4 * q) * 4);
            if (i + 1 < 64) {
#pragma unroll
                for (int q = 0; q < (i + 1 + 3) / 4 && q < 8; ++q) pre[(i + 1) & 1][q] = *(const LAS f32x4*)(lmb + ((i + 1) * 64 + 4 * q) * 4);
            }
            __builtin_amdgcn_sched_barrier(0);
            f32x2 A = (f32x2){(i == lane) ? 1.f : 0.f, 0.f}, B = (f32x2){0.f, 0.f};
#pragma unroll
            for (int jb = 0; jb < i; jb += 4) {
                const f32x4 l4 = ((jb >> 2) < 8) ? pre[i & 1][(jb >> 2) & 7] : late[((jb >> 2) - 8) & 7];
                f32x2 lo = (f32x2){l4.x, (jb + 1 < i) ? l4.y : 0.f}, hi = (f32x2){(jb + 2 < i) ? l4.z : 0.f, (jb + 3 < i) ? l4.w : 0.f};
                A -= lo * tv[jb >> 1];
                if (jb + 2 < i) B -= hi * tv[(jb >> 1) + 1];
            }
            const float ti = (A.x + A.y) + (B.x + B.y);
            if (i & 1) tv[i >> 1].y = ti; else tv[i >> 1].x = ti;
            __builtin_amdgcn_sched_barrier(0);
        }
        {
            const float sb = betal, sw = betal * __expf(gcl);
#pragma unroll
            for (int i = 0; i < 64; ++i) { const float tvv = (i & 1) ? tv[i >> 1].y : tv[i >> 1].x;
                *(LAS bf16*)(lds + PQ_TB + i * 144 + lane * 2) = (bf16)(pk2(tvv * sb, 0.f) & 0xffffu);
                *(LAS bf16*)(lds + PQ_TW + i * 144 + lane * 2) = (bf16)(pk2(tvv * sw, 0.f) & 0xffffu); }
        }
    }
    __syncthreads();
#pragma unroll
    for (int q2 = 0; q2 < 2; ++q2) {
        const int tc = 2 * ws4 + q2;
        const int trow = (fr >> 2), tcol = 16 * tc + 4 * (fr & 3);
        bf16x8 bv[2], ak[2];
#pragma unroll
        for (int kk = 0; kk < 2; ++kk) {
            const s16x4 v0 = vtr(lds + PQ_V + (32 * kk + 8 * fg + trow) * 272 + tcol * 2), v1 = vtr(lds + PQ_V + (32 * kk + 8 * fg + 4 + trow) * 272 + tcol * 2);
            const s16x4 k0 = vtr(lds + PQ_KN + (32 * kk + 8 * fg + trow) * 272 + tcol * 2), k1 = vtr(lds + PQ_KN + (32 * kk + 8 * fg + 4 + trow) * 272 + tcol * 2);
            bv[kk] = (bf16x8){v0[0], v0[1], v0[2], v0[3], v1[0], v1[1], v1[2], v1[3]};
            ak[kk] = (bf16x8){k0[0], k0[1], k0[2], k0[3], k1[0], k1[1], k1[2], k1[3]};
        }
#pragma unroll
        for (int ti = 0; ti < 4; ++ti) {
            bf16x8 tb[2], tw[2];
#pragma unroll
            for (int kk = 0; kk < 2; ++kk) { tb[kk] = lds8(lds + PQ_TB + (16 * ti + fr) * 144 + (32 * kk + 8 * fg) * 2); tw[kk] = lds8(lds + PQ_TW + (16 * ti + fr) * 144 + (32 * kk + 8 * fg) * 2); }
            f32x4 cu = (f32x4){0.f, 0.f, 0.f, 0.f}, cw2 = (f32x4){0.f, 0.f, 0.f, 0.f};
#pragma unroll
            for (int kk = 0; kk < 2; ++kk) { cu = mfma16(tb[kk], bv[kk], cu); cw2 = mfma16(ak[kk], tw[kk], cw2); }
            u32x2 ou; ou.x = pk2(cu[0], cu[1]); ou.y = pk2(cu[2], cu[3]);
            *(u32x2*)(gp + GP_UT + (16 * tc + fr) * 128 + (16 * ti + 4 * fg) * 2) = ou;
            u32x2 ow; ow.x = pk2(-cw2[0], -cw2[1]); ow.y = pk2(-cw2[2], -cw2[3]);
            *(u32x2*)(gp + GP_W + (16 * ti + fr) * 256 + (16 * tc + 4 * fg) * 2) = ow;
        }
    }
    __syncthreads();
}

__device__ __forceinline__ void p2_prep(const P& p, lptr lds, int G) {
    const int tid = threadIdx.x, lane = tid & 63, wave = tid >> 6;
    const int gw = blockIdx.x * 8 + wave, NGW = G * 8;
    unsigned char* ws = p.ws;
    const bool kn_fused = (G == 256);
    if (!kn_fused) { for (int m = gw; m < NT; m += 8 * NGW) knorm_rows8<8>((bf16*)(ws + WS_PROJ) + 512, NPROJ, m, NGW, NT, p.in[5], lane); }
    for (int s = ((gw & 15) == 0) ? (gw >> 4) : NB * 8; s < NB * 8; s += (NGW >> 4)) {
        const int b = s >> 3, h = s & 7; const float* gates = (const float*)(ws + WS_GATES) + (size_t)b * SEQ * 16 + h;
        float v[32]; float run = 0.f;
#pragma unroll
        for (int i = 0; i < 32; ++i) { run += gates[(size_t)(lane * 32 + i) * 16]; v[i] = run; }
        float tot = run;
#pragma unroll
        for (int o = 1; o < 64; o <<= 1) { const float t = __shfl_up(tot, o); if (lane >= o) tot += t; }
        const float off = tot - run;
        float* ck = (float*)(ws + WS_CK) + (size_t)s * SEQ + lane * 32;
#pragma unroll
        for (int i = 0; i < 32; ++i) ck[i] = -(v[i] + off) * LOG2E;
    }
    { int it = 0; for (int pair = blockIdx.x; pair < 1024; pair += G, ++it) gdn_prep_pair(p, lds, pair, (int)blockIdx.x * 128 + 32 * it, kn_fused ? 32 : 0); }
}
constexpr int SC_WL = 0, SC_QGL = 17408, SC_KDL = 34816, SC_UTL = 53248, SC_INL = 71680, SC_ST = 80896, SC_VNT = 115712, SC_SSQ = 134144, SC_RSTD = 136192;

__device__ __forceinline__ void gdn_scan_task(const P& p, lptr lds, int tsk) {
    int tid_ = threadIdx.x; asm volatile("" : "+v"(tid_));
    const int tid = tid_, lane = tid & 63, wave = __builtin_amdgcn_readfirstlane(tid >> 6), fr = lane & 15, fg = lane >> 4;
    const int b = tsk >> 2, h = tsk & 3;
    unsigned char* ws = p.ws;
    const unsigned char* gp0 = ws + WS_GP + (size_t)tsk * 32 * GP_CHUNK;
    const float* GL = (const float*)(ws + WS_GL) + tsk * 32;
    const bf16* zbase = (const bf16*)(ws + WS_PROJ) + (size_t)b * SEQ * NPROJ + 3072 + h * 128;
    bf16* mbase = (bf16*)(ws + WS_BUFA) + (size_t)b * SEQ * DM + 512 + h * 128;
    const int ecol = 16 * wave + fr;
    const float og = p.in[11][ecol];
    u32x4 pf[9];
    auto issue = [&](int n) {
        const unsigned char* g = gp0 + (size_t)n * GP_CHUNK;
#pragma unroll
        for (int k = 0; k < 2; ++k) { pf[k] = *(const u32x4*)(g + GP_W + (tid + 512 * k) * 16); pf[2 + k] = *(const u32x4*)(g + GP_QG + (tid + 512 * k) * 16);
            pf[4 + k] = *(const u32x4*)(g + GP_KDT + (tid + 512 * k) * 16); pf[6 + k] = *(const u32x4*)(g + GP_UT + (tid + 512 * k) * 16); }
        pf[8] = *(const u32x4*)(g + GP_IN + tid * 16);
    };
    auto commit = [&]() {
#pragma unroll
        for (int k = 0; k < 2; ++k) { const int q = tid + 512 * k;
            *(LAS u32x4*)(lds + SC_WL + (q >> 4) * 272 + (q & 15) * 16) = pf[k]; *(LAS u32x4*)(lds + SC_QGL + (q >> 4) * 272 + (q & 15) * 16) = pf[2 + k];
            *(LAS u32x4*)(lds + SC_KDL + (q >> 4) * 272 + (q & 15) * 16) = pf[4 + k]; *(LAS u32x4*)(lds + SC_UTL + (q >> 3) * 144 + (q & 7) * 16) = pf[6 + k]; }
        *(LAS u32x4*)(lds + SC_INL + (tid >> 3) * 144 + (tid & 7) * 16) = pf[8];
    };
    f32x4 sacc[8];
#pragma unroll
    for (int td = 0; td < 8; ++td) sacc[td] = (f32x4){0.f, 0.f, 0.f, 0.f};
    for (int q = lane; q < 272; q += 64) *(LAS u32x4*)(lds + SC_ST + (16 * wave) * 272 + q * 16) = (u32x4){0u, 0u, 0u, 0u};
    issue(0); commit();
    __syncthreads();
    for (int n = 0; n < 32; ++n) {
#ifndef X_NOLOAD
        if (n + 1 < 32) issue(n + 1);
#endif
        const float eg = GL[n];
        const unsigned zoff0 = (unsigned)((n * 64 + 4 * fg) * NPROJ + ecol), moff0 = (unsigned)((n * 64 + 4 * fg) * DM + ecol);
        unsigned short zr[16];
#pragma unroll
        for (int ti = 0; ti < 4; ++ti)
#pragma unroll
            for (int e = 0; e < 4; ++e) {
#ifndef X_NOEPI
                zr[ti * 4 + e] = zbase[zoff0 + (unsigned)((16 * ti + e) * NPROJ)];
#else
                zr[ti * 4 + e] = 0x3f80;
#endif
            }
        bf16x8 bs[4];
        f32x4 acc[4];
#pragma unroll
        for (int kk = 0; kk < 4; ++kk) bs[kk] = lds8(lds + SC_ST + ecol * 272 + (32 * kk + 8 * fg) * 2);
#pragma unroll
        for (int th = 0; th < 2; ++th) {
            bf16x8 wa[2][4]; u32x2 uu[2];
#pragma unroll
            for (int t2 = 0; t2 < 2; ++t2) { const int ti = 2 * th + t2;
                uu[t2] = *(const LAS u32x2*)(lds + SC_UTL + ecol * 144 + (16 * ti + 4 * fg) * 2);
#pragma unroll
                for (int kk = 0; kk < 4; ++kk) wa[t2][kk] = lds8(lds + SC_WL + (16 * ti + fr) * 272 + (32 * kk + 8 * fg) * 2);
            }
            __builtin_amdgcn_sched_barrier(0);
#pragma unroll
            for (int t2 = 0; t2 < 2; ++t2) acc[2 * th + t2] = (f32x4){bflo(uu[t2].x), bfhi(uu[t2].x), bflo(uu[t2].y), bfhi(uu[t2].y)};
            __builtin_amdgcn_s_setprio(1);
#pragma unroll
            for (int kk = 0; kk < 4; ++kk)
#pragma unroll
                for (int t2 = 0; t2 < 2; ++t2) acc[2 * th + t2] = mfma16(wa[t2][kk], bs[kk], acc[2 * th + t2]);
            __builtin_amdgcn_s_setprio(0);
#pragma unroll
            for (int t2 = 0; t2 < 2; ++t2) { const int ti = 2 * th + t2;
                u32x2 o; o.x = pk2(acc[ti][0], acc[ti][1]); o.y = pk2(acc[ti][2], acc[ti][3]);
                *(LAS u32x2*)(lds + SC_VNT + ecol * 144 + (16 * ti + 4 * fg) * 2) = o;
            }
            __builtin_amdgcn_sched_barrier(0);
        }
        LDS_WAIT();
        bf16x8 vn[2];
        f32x4 oacc[4];
#pragma unroll
        for (int kk = 0; kk < 2; ++kk) vn[kk] = lds8(lds + SC_VNT + ecol * 144 + (32 * kk + 8 * fg) * 2);
#pragma unroll
        for (int th = 0; th < 2; ++th) {
            bf16x8 qa[2][4], ia[2][2];
#pragma unroll
            for (int t2 = 0; t2 < 2; ++t2) { const int ti = 2 * th + t2;
#pragma unroll
                for (int kk = 0; kk < 4; ++kk) qa[t2][kk] = lds8(lds + SC_QGL + (16 * ti + fr) * 272 + (32 * kk + 8 * fg) * 2);
#pragma unroll
                for (int kk = 0; kk < 2; ++kk) ia[t2][kk] = lds8(lds + SC_INL + (16 * ti + fr) * 144 + (32 * kk + 8 * fg) * 2);
            }
            __builtin_amdgcn_sched_barrier(0);
#pragma unroll
            for (int t2 = 0; t2 < 2; ++t2) oacc[2 * th + t2] = (f32x4){0.f, 0.f, 0.f, 0.f};
            __builtin_amdgcn_s_setprio(1);
#pragma unroll
            for (int kk = 0; kk < 4; ++kk)
#pragma unroll
                for (int t2 = 0; t2 < 2; ++t2) oacc[2 * th + t2] = mfma16(qa[t2][kk], bs[kk], oacc[2 * th + t2]);
#pragma unroll
            for (int kk = 0; kk < 2; ++kk)
#pragma unroll
                for (int t2 = 0; t2 < 2; ++t2) oacc[2 * th + t2] = mfma16(ia[t2][kk], vn[kk], oacc[2 * th + t2]);
            __builtin_amdgcn_s_setprio(0);
            __builtin_amdgcn_sched_barrier(0);
        }
#pragma unroll
        for (int th = 0; th < 2; ++th) {
            bf16x8 ka[4][2];
#pragma unroll
            for (int t4 = 0; t4 < 4; ++t4)
#pragma unroll
                for (int kk = 0; kk < 2; ++kk) {
                    const lptr ap = lds + SC_KDL + (32 * kk + 8 * fg + (fr >> 2)) * 272 + (16 * (4 * th + t4) + 4 * (fr & 3)) * 2;
                    const s16x4 a0 = vtr(ap), a1 = vtr(ap + 4 * 272);
                    ka[t4][kk] = (bf16x8){a0[0], a0[1], a0[2], a0[3], a1[0], a1[1], a1[2], a1[3]};
                }
            __builtin_amdgcn_sched_barrier(0);
#pragma unroll
            for (int t4 = 0; t4 < 4; ++t4) sacc[4 * th + t4] = sacc[4 * th + t4] * eg;
            __builtin_amdgcn_s_setprio(1);
#pragma unroll
            for (int kk = 0; kk < 2; ++kk)
#pragma unroll
                for (int t4 = 0; t4 < 4; ++t4) sacc[4 * th + t4] = mfma16(ka[t4][kk], vn[kk], sacc[4 * th + t4]);
            __builtin_amdgcn_s_setprio(0);
#pragma unroll
            for (int t4 = 0; t4 < 4; ++t4) { const int td = 4 * th + t4;
                u32x2 o; o.x = pk2(sacc[td][0], sacc[td][1]); o.y = pk2(sacc[td][2], sacc[td][3]);
                *(LAS u32x2*)(lds + SC_ST + ecol * 272 + (16 * td + 4 * fg) * 2) = o;
            }
            __builtin_amdgcn_sched_barrier(0);
        }
        {
            f32x4 sq[4];
#pragma unroll
            for (int ti = 0; ti < 4; ++ti)
#pragma unroll
                for (int e = 0; e < 4; ++e) sq[ti][e] = row16_sum(oacc[ti][e] * oacc[ti][e]);
            if (fr == 0) {
#pragma unroll
                for (int ti = 0; ti < 4; ++ti) *(LAS f32x4*)(lds + SC_SSQ + (wave * 64 + 16 * ti + 4 * fg) * 4) = sq[ti];
            }
        }
        LDS_WAIT(); __builtin_amdgcn_s_barrier(); asm volatile("" ::: "memory");
#ifndef X_NOLOAD
        if (n + 1 < 32) commit();
#endif
        if (tid < 64) { float s = 0.f;
#pragma unroll
            for (int w = 0; w < 8; ++w) s += ((const LAS float*)(lds + SC_SSQ))[w * 64 + tid];
            ((LAS float*)(lds + SC_RSTD))[tid] = rsqrtf(s * (1.f / 128.f) + EPS); }
        LDS_WAIT(); __builtin_amdgcn_s_barrier(); asm volatile("" ::: "memory");
#pragma unroll
        for (int ti = 0; ti < 4; ++ti) {
            const f32x4 rs = *(const LAS f32x4*)(lds + SC_RSTD + (16 * ti + 4 * fg) * 4);
#pragma unroll
            for (int e = 0; e < 4; ++e) {
                const float z = __uint_as_float((unsigned)zr[ti * 4 + e] << 16);
                const float v = oacc[ti][e] * rs[e] * og * siluf(z);
#ifndef X_NOEPI
                mbase[moff0 + (unsigned)((16 * ti + e) * DM)] = (bf16)(pk2(v, 0.f) & 0xffffu);
#else
                if (v == 123.456f) mix[0] = 0;
#endif
            }
        }
    }
    __syncthreads();
}

constexpr int AT_ALPHA = 70144, AT_OST = 73728;
__device__ __forceinline__ int crow(int r, int hi) { return (r & 3) + 8 * (r >> 2) + 4 * hi; }

template <int D, bool FOX>
__device__ __forceinline__ void attn_unit(lptr lds, const bf16* Qp, int qpitch, const bf16* Kp, const bf16* Vp, int kvpitch, int ntiles, int q0,
                                          const float* qgain, float qscale, const float* bias, bf16* Op, int opitch, const float* ogain) {
    constexpr int PITCH = D * 2 + 16, TILEB = 64 * PITCH, ND = D / 16, NDB = D / 32, NCH = D / 64;
    constexpr int OFF_K = 0, OFF_V = 2 * TILEB, OFF_B = 4 * TILEB;
    int tid_ = threadIdx.x; asm volatile("" : "+v"(tid_));
    const int tid = tid_, lane = tid & 63, wave = __builtin_amdgcn_readfirstlane(tid >> 6), r32 = lane & 31, hi = lane >> 5;
    bf16x8 qf[ND];
    {
        const bf16* qrow = Qp + (size_t)(32 * wave + r32) * qpitch;
        float qv[ND][8]; float ss = 0.f;
#pragma unroll
        for (int d0 = 0; d0 < ND; ++d0) { const u32x4 raw = *(const u32x4*)(qrow + 16 * d0 + 8 * hi);
            qv[d0][0] = bflo(raw.x); qv[d0][1] = bfhi(raw.x); qv[d0][2] = bflo(raw.y); qv[d0][3] = bfhi(raw.y); qv[d0][4] = bflo(raw.z); qv[d0][5] = bfhi(raw.z); qv[d0][6] = bflo(raw.w); qv[d0][7] = bfhi(raw.w);
#pragma unroll
            for (int e = 0; e < 8; ++e) ss += qv[d0][e] * qv[d0][e]; }
        ss += xor32(ss);
        const float rs = rsqrtf(ss * (1.f / D) + EPS) * qscale;
#pragma unroll
        for (int d0 = 0; d0 < ND; ++d0) { const f32x4 g0 = *(const f32x4*)(qgain + 16 * d0 + 8 * hi), g1 = *(const f32x4*)(qgain + 16 * d0 + 8 * hi + 4);
            u32x4 o; o.x = pk2(qv[d0][0] * rs * g0.x, qv[d0][1] * rs * g0.y); o.y = pk2(qv[d0][2] * rs * g0.z, qv[d0][3] * rs * g0.w);
            o.z = pk2(qv[d0][4] * rs * g1.x, qv[d0][5] * rs * g1.y); o.w = pk2(qv[d0][6] * rs * g1.z, qv[d0][7] * rs * g1.w);
            qf[d0] = __builtin_bit_cast(bf16x8, o); }
    }
    f32x16 o[NDB];
#pragma unroll
    for (int db = 0; db < NDB; ++db) o[db] = f32x16{};
    float lrun = 0.f;
    const int wave_last = FOX ? ((q0 + 32 * wave + 31) >> 6) : (ntiles - 1);
    const int qpos = q0 + 32 * wave + r32;
    const float mref = (FOX ? bias[qpos] : 0.f) + 8.f;
    constexpr int DEPTH = (D == 64) ? 3 : 1;
    u32x4 kr[DEPTH][NCH], vr[DEPTH][NCH]; float br[DEPTH];
#define AT_ISSUE(slot, kt_) do { _Pragma("unroll") for (int c = 0; c < NCH; ++c) { const int q = tid + 512 * c, row = q / (D / 8), cc = q % (D / 8); \
            kr[slot][c] = *(const u32x4*)(Kp + (size_t)((kt_) * 64 + row) * kvpitch + cc * 8); vr[slot][c] = *(const u32x4*)(Vp + (size_t)((kt_) * 64 + row) * kvpitch + cc * 8); } \
        br[slot] = 0.f; if (FOX && tid < 64) br[slot] = bias[(kt_) * 64 + tid]; } while (0)
#define AT_COMMIT(slot, buf_) do { _Pragma("unroll") for (int c = 0; c < NCH; ++c) { const int q = tid + 512 * c, row = q / (D / 8), cc = q % (D / 8); \
            *(LAS u32x4*)(lds + OFF_K + (buf_) * TILEB + row * PITCH + cc * 16) = kr[slot][c]; *(LAS u32x4*)(lds + OFF_V + (buf_) * TILEB + row * PITCH + cc * 16) = vr[slot][c]; } \
        if (FOX && tid < 64) ((LAS float*)(lds + OFF_B + (buf_) * 256))[tid] = br[slot]; } while (0)
    LAS float* alpha = (LAS float*)(lds + AT_ALPHA + wave * 128);
    AT_ISSUE(0, 0); AT_COMMIT(0, 0);
#pragma unroll
    for (int d = 1; d < DEPTH; ++d) { if (d < ntiles) AT_ISSUE(d, d); }
    __syncthreads();
    for (int kt0 = 0; kt0 < ntiles; kt0 += DEPTH) {
#pragma unroll
      for (int jj = 0; jj < DEPTH; ++jj) {
        const int kt = kt0 + jj;
        if (kt < ntiles) {
        const int buf = kt & 1;
        if (kt + DEPTH < ntiles) AT_ISSUE(jj, kt + DEPTH);
        if (kt <= wave_last) {
            f32x16 p0, p1;
            if (FOX) {
#pragma unroll
                for (int a = 0; a < 4; ++a) { const f32x4 b0 = *(const LAS f32x4*)(lds + OFF_B + buf * 256 + (8 * a + 4 * hi) * 4), b1 = *(const LAS f32x4*)(lds + OFF_B + buf * 256 + (32 + 8 * a + 4 * hi) * 4);
#pragma unroll
                    for (int e = 0; e < 4; ++e) { p0[4 * a + e] = b0[e]; p1[4 * a + e] = b1[e]; } }
            } else {
#pragma unroll
                for (int r = 0; r < 16; ++r) { p0[r] = -mref; p1[r] = -mref; } }
            const lptr kb = lds + OFF_K + buf * TILEB + r32 * PITCH + hi * 16;
#pragma unroll
            for (int dh = 0; dh < ND / 4; ++dh) {
                bf16x8 kf0[4], kf1[4];
#pragma unroll
                for (int d0 = 0; d0 < 4; ++d0) { kf0[d0] = lds8(kb + (4 * dh + d0) * 32); kf1[d0] = lds8(kb + 32 * PITCH + (4 * dh + d0) * 32); }
                __builtin_amdgcn_sched_barrier(0);
                __builtin_amdgcn_s_setprio(1);
#pragma unroll
                for (int d0 = 0; d0 < 4; ++d0) { p0 = mfma32(kf0[d0], qf[4 * dh + d0], p0); p1 = mfma32(kf1[d0], qf[4 * dh + d0], p1); }
                __builtin_amdgcn_s_setprio(0);
                __builtin_amdgcn_sched_barrier(0);
            }
            const lptr vb = lds + OFF_V + buf * TILEB + (4 * hi + ((lane & 15) >> 2)) * PITCH + (((lane >> 4) & 1) * 16 + (lane & 3) * 4) * 2;
            s16x4 vlo[2][4], vhh[2][4];
#pragma unroll
            for (int db = 0; db < 2; ++db)
#pragma unroll
                for (int s = 0; s < 4; ++s) { vlo[db][s] = vtr(vb + (16 * s) * PITCH + db * 64); vhh[db][s] = vtr(vb + (16 * s + 8) * PITCH + db * 64); }
            __builtin_amdgcn_sched_barrier(0);
            if (FOX && (kt * 64 + 63 > q0 + 32 * wave)) {
#pragma unroll
                for (int r = 0; r < 16; ++r) { const int key = kt * 64 + crow(r, hi); if (key > qpos) p0[r] = -INFINITY; if (key + 32 > qpos) p1[r] = -INFINITY; }
            }
            if (FOX) { p0 = p0 - mref; p1 = p1 - mref; }
#pragma unroll
            for (int r = 0; r < 16; ++r) { p0[r] = __builtin_amdgcn_exp2f(p0[r]); p1[r] = __builtin_amdgcn_exp2f(p1[r]); }
            {
                const f32x16 ps = p0 + p1;
                const float ls = ((ps[0] + ps[1]) + (ps[2] + ps[3])) + ((ps[4] + ps[5]) + (ps[6] + ps[7])) + (((ps[8] + ps[9]) + (ps[10] + ps[11])) + ((ps[12] + ps[13]) + (ps[14] + ps[15])));
                lrun += ls;
            }
            bf16x8 pa[4];
            { u32x4 w;
              w.x = pk2(p0[0], p0[1]); w.y = pk2(p0[2], p0[3]); w.z = pk2(p0[4], p0[5]); w.w = pk2(p0[6], p0[7]); pa[0] = __builtin_bit_cast(bf16x8, w);
              w.x = pk2(p0[8], p0[9]); w.y = pk2(p0[10], p0[11]); w.z = pk2(p0[12], p0[13]); w.w = pk2(p0[14], p0[15]); pa[1] = __builtin_bit_cast(bf16x8, w);
              w.x = pk2(p1[0], p1[1]); w.y = pk2(p1[2], p1[3]); w.z = pk2(p1[4], p1[5]); w.w = pk2(p1[6], p1[7]); pa[2] = __builtin_bit_cast(bf16x8, w);
              w.x = pk2(p1[8], p1[9]); w.y = pk2(p1[10], p1[11]); w.z = pk2(p1[12], p1[13]); w.w = pk2(p1[14], p1[15]); pa[3] = __builtin_bit_cast(bf16x8, w); }
#pragma unroll
            for (int dp = 0; dp < NDB / 2; ++dp) {
                if (dp > 0) {
#pragma unroll
                    for (int db = 0; db < 2; ++db)
#pragma unroll
                        for (int s = 0; s < 4; ++s) { vlo[db][s] = vtr(vb + (16 * s) * PITCH + (2 * dp + db) * 64); vhh[db][s] = vtr(vb + (16 * s + 8) * PITCH + (2 * dp + db) * 64); }
                    __builtin_amdgcn_sched_barrier(0);
                }
                __builtin_amdgcn_s_setprio(1);
#pragma unroll
                for (int db = 0; db < 2; ++db)
#pragma unroll
                    for (int s = 0; s < 4; ++s) {
                        const bf16x8 vf = (bf16x8){vlo[db][s][0], vlo[db][s][1], vlo[db][s][2], vlo[db][s][3], vhh[db][s][0], vhh[db][s][1], vhh[db][s][2], vhh[db][s][3]};
                        o[2 * dp + db] = mfma32(pa[s], vf, o[2 * dp + db]);
                    }
                __builtin_amdgcn_s_setprio(0);
            }
        }
        if (kt + 1 < ntiles) AT_COMMIT((jj + 1) % DEPTH, buf ^ 1);
        __syncthreads();
        }
      }
    }
#undef AT_ISSUE
#undef AT_COMMIT
    lrun += xor32(lrun);
    if (hi == 0) alpha[r32] = 1.f / lrun;
    LDS_WAIT();
    f32x4 inv[4];
#pragma unroll
    for (int a = 0; a < 4; ++a) inv[a] = *(const LAS f32x4*)((lptr)alpha + (8 * a + 4 * hi) * 4);
    LAS float* ost = (LAS float*)(lds + AT_OST + wave * 8704);
#pragma unroll
    for (int ps = 0; ps < NDB / 2; ++ps) {
#pragma unroll
        for (int dbl = 0; dbl < 2; ++dbl)
#pragma unroll
            for (int r = 0; r < 16; ++r) ost[crow(r, hi) * 68 + dbl * 32 + r32] = o[ps * 2 + dbl][r] * inv[r >> 2][r & 3];
        LDS_WAIT();
        const int q = lane >> 1, half = lane & 1;
        float v[32]; float ss = 0.f;
#pragma unroll
        for (int c = 0; c < 8; ++c) { const f32x4 t = *(const LAS f32x4*)((lptr)ost + (q * 68 + half * 32 + 4 * c) * 4); v[4 * c] = t.x; v[4 * c + 1] = t.y; v[4 * c + 2] = t.z; v[4 * c + 3] = t.w; }
        float rs = 1.f;
        if (FOX) {
#pragma unroll
            for (int e = 0; e < 32; ++e) ss += v[e] * v[e];
            ss = dpp_add<0xB1>(ss);
            rs = rsqrtf(ss * (1.f / 64.f) + EPS);
        }
        bf16* op = Op + (size_t)(32 * wave + q) * opitch + ps * 64 + half * 32;
#pragma unroll
        for (int c = 0; c < 4; ++c) {
            float g[8];
#pragma unroll
            for (int e = 0; e < 8; ++e) g[e] = FOX ? ogain[half * 32 + 8 * c + e] * rs : 1.f;
            u32x4 w; w.x = pk2(v[8 * c] * g[0], v[8 * c + 1] * g[1]); w.y = pk2(v[8 * c + 2] * g[2], v[8 * c + 3] * g[3]); w.z = pk2(v[8 * c + 4] * g[4], v[8 * c + 5] * g[5]); w.w = pk2(v[8 * c + 6] * g[6], v[8 * c + 7] * g[7]);
            *(u32x4*)(op + 8 * c) = w;
        }
        LDS_WAIT();
    }
    __syncthreads();
}
#define XB_TMO      128
#define XB_XCNT(j)  (256  + 64 * (j))
#define XB_XSUB(j)  (1280 + 64 * (j))
#define XB_XGEN(j)  (2304 + 64 * (j))
#define XB_TOP      3328
#define XB_TOPGEN   3392
#define XCD_BAR_WORDS 3456
#define XB_SPIN_CAP (1u << 18)

__device__ __forceinline__ unsigned xb_ld(unsigned* p)              { return __hip_atomic_load(p, __ATOMIC_RELAXED, __HIP_MEMORY_SCOPE_AGENT); }
__device__ __forceinline__ unsigned xb_add(unsigned* p, unsigned v) { return __hip_atomic_fetch_add(p, v, __ATOMIC_RELAXED, __HIP_MEMORY_SCOPE_AGENT); }
__device__ __forceinline__ unsigned xb_xcc_id() { return (unsigned)__builtin_amdgcn_s_getreg((3 << 11) | 20) & 0xFu; }
#define XB_SPIN(cond, bar) do { unsigned _sp = 0; while (cond) { __builtin_amdgcn_s_sleep(1); \
    if ((++_sp & 255u) == 0u) { if (xb_ld(&(bar)[XB_TMO])) break; if (_sp > XB_SPIN_CAP) { atomicAdd(&(bar)[XB_TMO], 1u); break; } } } } while (0)

struct XcdBarrier {
    unsigned* bar; unsigned x;
    volatile LAS unsigned* st;
};

__device__ __forceinline__ XcdBarrier xcd_barrier_post(unsigned* bar, volatile LAS unsigned* st) {
    XcdBarrier b; b.bar = bar; b.x = xb_xcc_id(); b.st = st;
    if (threadIdx.x == 0) (void)xb_add(&bar[XB_XCNT(b.x)], 1u);
    return b;
}
__device__ __forceinline__ void xcd_barrier_complete(unsigned* bar, unsigned x, unsigned& nloc, unsigned& nx) {
    const unsigned G = gridDim.x * gridDim.y * gridDim.z;
    unsigned sum, cnt, mine, sp = 0u;
    for (;;) {
        sum = 0u; cnt = 0u; mine = 0u;
#pragma unroll
        for (unsigned j = 0; j < 16; ++j) { const unsigned c = xb_ld(&bar[XB_XCNT(j)]); sum += c; cnt += (c > 0u) ? 1u : 0u; mine = (j == x) ? c : mine; }
        if (sum == G) break;
        __builtin_amdgcn_s_sleep(1);
        if ((++sp & 255u) == 0u) { if (xb_ld(&bar[XB_TMO])) break; if (sp > XB_SPIN_CAP) { atomicAdd(&bar[XB_TMO], 1u); break; } }
    }
    nloc = mine > 0u ? mine : 1u; nx = cnt > 0u ? cnt : 1u;
}

__device__ __forceinline__ void xcd_barrier(const XcdBarrier& b) {
    asm volatile("s_waitcnt vmcnt(0)" ::: "memory");
    __syncthreads();
    if (threadIdx.x == 0) {
        unsigned* bar = b.bar;
        __builtin_amdgcn_s_waitcnt(0);
        unsigned nloc = b.st[0], nx = b.st[1];
        if (nloc == 0u) { xcd_barrier_complete(bar, b.x, nloc, nx); b.st[0] = nloc; b.st[1] = nx; }
        const unsigned old = xb_add(&bar[XB_XSUB(b.x)], 1u);
        const unsigned gen = old / nloc;
        if (old + 1u == (gen + 1u) * nloc) {
            __builtin_amdgcn_fence(__ATOMIC_RELEASE, "agent");
            asm volatile("s_waitcnt vmcnt(0)" ::: "memory");
            const unsigned og = xb_add(&bar[XB_TOP], 1u);
            const unsigned tg = og / nx;
            if (og + 1u == (tg + 1u) * nx) xb_add(&bar[XB_TOPGEN], 1u);
            else XB_SPIN(xb_ld(&bar[XB_TOPGEN]) == tg, bar);
            __builtin_amdgcn_fence(__ATOMIC_ACQUIRE, "agent");
            xb_add(&bar[XB_XGEN(b.x)], 1u);
            asm volatile("s_waitcnt vmcnt(0)" ::: "memory");
        } else {
            XB_SPIN(xb_ld(&bar[XB_XGEN(b.x)]) == gen, bar);
            __builtin_amdgcn_fence(__ATOMIC_ACQUIRE, "agent");
            asm volatile("s_waitcnt vmcnt(0)" ::: "memory");
        }
    }
    __syncthreads();
}

struct Args { P p; int ph_lo, ph_hi; };

__global__ void __launch_bounds__(512, 2) fwd(Args a) {
    extern __shared__ __attribute__((aligned(16))) unsigned char lds_raw[];
    const lptr lds = (lptr)lds_raw;
    const P& p = a.p;
    const int G = gridDim.x, tid = threadIdx.x;
    unsigned char* ws = p.ws;
    cg::grid_group grid = cg::this_grid();
    const int lo = a.ph_lo, hi = a.ph_hi;
    volatile LAS unsigned* xst = (volatile LAS unsigned*)(lds + LDS_MISC + 16);
    if (tid == 0) { xst[0] = 0u; xst[1] = 0u; }
    __syncthreads();
    XcdBarrier xbar = xcd_barrier_post((unsigned*)(ws + WS_BARW), xst);
#ifndef PH_MASK
#define PH_MASK 0x3ff
#endif
#define IN(k) (((PH_MASK >> (k)) & 1) && lo <= (k) && (k) < hi)
#ifdef PROBE_PH
#define STAMP(k) do { if (blockIdx.x == 0 && tid == 0) ((unsigned long long*)(ws + WS_CTL + 1024))[k] = __builtin_amdgcn_s_memrealtime(); } while (0)
#else
#define STAMP(k) do { } while (0)
#endif
#define SEAM(k) do { if (IN((k) + 1)) xcd_barrier(xbar); STAMP((k) + 1); } while (0)
    if (a.ph_hi > NPH + 100) grid.sync();
    STAMP(0);
    typedef pg8::bf16_t pb;
    if (IN(0)) { p0_prologue(p, lds, G); SEAM(0); }
    if (IN(1)) {
        { pg8::Gemm g{(const pb*)(ws + WS_BUFA), (const pb*)(ws + WS_WIN), NT, NPROJ, DM}; pg8::StaticOrder S; S.init(NT, NPROJ, G, (int)blockIdx.x);
          pg8::EpiStore<0, false> E{(pb*)(ws + WS_PROJ), NPROJ, nullptr};
          pg8::gemm_phase<pg8::EpiStore<0, false>, pg8::StaticOrder, true, true>(lds, g, S, E); }
        SEAM(1);
    }
    if (IN(2)) { p2_prep(p, lds, G); SEAM(2); }
    if (IN(3)) {
        unsigned* ctr = (unsigned*)(ws + WS_CTL);
        volatile LAS unsigned* slot = (volatile LAS unsigned*)(lds + LDS_MISC);
        for (;;) {
            __syncthreads();
            if (tid == 0) *slot = atomicAdd(ctr, 1u);
            __syncthreads();
            const unsigned tk = *slot;
            const unsigned id = (tk >= 576u && tk < 640u) ? (1088u + (tk - 576u)) : ((tk >= 640u && tk < 1152u) ? (tk - 64u) : tk);
            if (id >= 64u + 1024u + 64u + (unsigned)(LATE_ITEMS / 16)) break;
            if (id >= 64u + 1024u + 64u) {
                const int t = (int)(id - (64u + 1024u + 64u));
                int tl = threadIdx.x; asm volatile("" : "+v"(tl));
                const int wv = __builtin_amdgcn_readfirstlane(tl >> 6);
                for (int r2 = 0; r2 < 2; ++r2) late_transpose_item(p, (LAS float*)(lds + 65536 + wv * 8448), 16 * t + 8 * r2 + wv, tl & 63);
            }
            else if (id >= 64u + 1024u) {
                const unsigned gu = id - (64u + 1024u);
                pg8::Gemm g{(const pb*)(ws + WS_HM), (const pb*)(ws + WS_WCKV), MEMR, 1024, DM};
                pg8::OneUnit S{(int)(gu >> 2), (int)(gu & 3)};
                pg8::EpiStore<0, false> E{(pb*)(ws + WS_CKV), 1024, nullptr};
                pg8::gemm_phase<pg8::EpiStore<0, false>, pg8::OneUnit, true, true>(lds, g, S, E);
            }
            else if (id < 64u) {
#ifndef NO_SCAN
                gdn_scan_task(p, lds, (int)id);
#endif
            }
#ifndef NO_ATTN
            else {
                const int idx = (int)id - 64, qb = 7 - (idx >> 7), bh = idx & 127, b = bh >> 3, h = bh & 7;
                const bf16* proj = (const bf16*)(ws + WS_PROJ);
                const size_t r0 = (size_t)b * SEQ;
                attn_unit<64, true>(lds, proj + (r0 + 256 * qb) * NPROJ + h * 64, NPROJ, proj + r0 * NPROJ + 512 + h * 64, proj + r0 * NPROJ + 1024 + h * 64, NPROJ,
                                    4 * qb + 4, 256 * qb, p.in[4], 0.125f * LOG2E, (const float*)(ws + WS_CK) + (size_t)bh * SEQ,
                                    (bf16*)(ws + WS_BUFA) + (r0 + 256 * qb) * DM + h * 64, DM, p.in[7]);
            }
#endif
        }
        SEAM(3);
    }
    if (IN(4)) {
        { const int lane = tid & 63, gw = blockIdx.x * 8 + (tid >> 6), NGW = G * 8;
          for (int m = gw; m < MEMR; m += 8 * NGW) knorm_rows8<16>((bf16*)(ws + WS_CKV), 1024, m, NGW, MEMR, p.in[18], lane); }
        pg8::Gemm g{(const pb*)(ws + WS_BUFA), (const pb*)(ws + WS_WOUT), NT, DM, DM}; pg8::StaticOrder S; S.init(NT, DM, G, (int)blockIdx.x);
        pg8::EpiRes<false, false> E{p.in[0], nullptr, (pb*)(ws + WS_XB1), (float*)(ws + WS_SSQ1)};
        pg8::gemm_phase<pg8::EpiRes<false, false>, pg8::StaticOrder, true, true>(lds, g, S, E);
        SEAM(4);
    }
    if (IN(5)) {
        pg8::Gemm g{(const pb*)(ws + WS_XB1), (const pb*)(ws + WS_WCQ), NT, 512, DM}; pg8::StaticOrder S; S.init(NT, 512, G, (int)blockIdx.x);
        pg8::EpiStore<0, true> E{(pb*)(ws + WS_CQ), 512, (const float*)(ws + WS_SSQ1)};
        pg8::gemm_phase<pg8::EpiStore<0, true>, pg8::StaticOrder, true, true>(lds, g, S, E);
        SEAM(5);
    }
    if (IN(6)) {
        for (int ui = 2 * (int)blockIdx.x; ui < 512; ui += 2 * G)
        for (int u = ui; u < ui + 2 && u < 512; ++u) {
            const int qb = u & 7, bh = u >> 3, b = bh >> 2, h = bh & 3;
            const bf16* cq = (const bf16*)(ws + WS_CQ); const bf16* ckv = (const bf16*)(ws + WS_CKV);
            const size_t r0 = (size_t)b * SEQ + 256 * qb;
            attn_unit<128, false>(lds, cq + r0 * 512 + h * 128, 512, ckv + (size_t)b * 256 * 1024 + h * 128, ckv + (size_t)b * 256 * 1024 + 512 + h * 128, 1024,
                                  4, 0, p.in[17], 0.08838834764831845f * LOG2E, nullptr, (bf16*)(ws + WS_CO) + r0 * 512 + h * 128, 512, nullptr);
        }
        SEAM(6);
    }
    if (IN(7)) {
        pg8::Gemm g{(const pb*)(ws + WS_CO), (const pb*)(ws + WS_WCO), NT, DM, 512}; pg8::StaticOrder S; S.init(NT, DM, G, (int)blockIdx.x);
        pg8::EpiRes<true, false> E{(const void*)(ws + WS_XB1), nullptr, (pb*)(ws + WS_BUFA), (float*)(ws + WS_SSQ2)};
        pg8::gemm_phase<pg8::EpiRes<true, false>, pg8::StaticOrder, true, true>(lds, g, S, E);
        SEAM(7);
    }
    if (IN(8)) {
        pg8::Gemm g{(const pb*)(ws + WS_BUFA), (const pb*)(ws + WS_W1), NT, DFF, DM}; pg8::StaticOrder S; S.init(NT, DFF, G, (int)blockIdx.x);
        pg8::EpiStore<2, true> E{(pb*)(ws + WS_HMID), DFF, (const float*)(ws + WS_SSQ2)};
        pg8::gemm_phase<pg8::EpiStore<2, true>, pg8::StaticOrder, true, true>(lds, g, S, E);
        SEAM(8);
    }
    if (IN(9)) {
        pg8::Gemm g{(const pb*)(ws + WS_HMID), (const pb*)(ws + WS_W2), NT, DM, DFF}; pg8::StaticOrder S; S.init(NT, DM, G, (int)blockIdx.x);
        pg8::EpiRes<true, true> E{(const void*)(ws + WS_BUFA), p.out, nullptr, nullptr};
        pg8::gemm_phase<pg8::EpiRes<true, true>, pg8::StaticOrder, true, true>(lds, g, S, E);
    }
#ifdef PROBE_PH
    grid.sync(); STAMP(10);
    if (blockIdx.x == 0 && tid == 0) { const unsigned long long* ts = (const unsigned long long*)(ws + WS_CTL + 1024); p.out[0] = (float)(ts[PROBE_PH + 1] - ts[PROBE_PH]) * 0.01f; }
#endif
#ifdef DBG_DUMP
    if (hi == NPH + 1 || lo == NPH) {
        const bf16* src = (const bf16*)(ws + (size_t)DBG_DUMP);
        for (size_t i = (size_t)blockIdx.x * 512 + tid; i < (size_t)NT * DM; i += (size_t)G * 512) p.out[i] = __uint_as_float((unsigned)src[i] << 16);
    }
#endif
#undef IN
#undef SEAM
}

extern "C" void kernel_launch(void* const* d_in, const int* in_sizes, int n_in, void* d_out, int out_size, void* d_ws, size_t ws_size, hipStream_t stream) {
    static int grid = 0;
    if (grid == 0) {
        if (n_in != 23 || out_size != NT * DM || ws_size < WS_END) { fprintf(stderr, "kernel_launch: unexpected shapes (n_in %d out %d ws %zu)\n", n_in, out_size, ws_size); grid = -1; return; }
        int dev = 0, cus = 0, per_cu = 0;
        (void)hipGetDevice(&dev); (void)hipDeviceGetAttribute(&cus, hipDeviceAttributeMultiprocessorCount, dev);
        if (hipFuncSetAttribute((const void*)fwd, hipFuncAttributeMaxDynamicSharedMemorySize, LDS_BYTES) != hipSuccess) { fprintf(stderr, "kernel_launch: hipFuncSetAttribute failed\n"); grid = -1; return; }
        if (hipOccupancyMaxActiveBlocksPerMultiprocessor(&per_cu, (const void*)fwd, 512, LDS_BYTES) != hipSuccess || per_cu < 1) { fprintf(stderr, "kernel_launch: occupancy query says %d\n", per_cu); per_cu = 1; }
        (void)hipGetLastError();
        grid = cus * (per_cu < 1 ? 1 : 1);
        if (grid <= 0) grid = 256;
    }
    if (grid < 0) return;
    if (hipMemsetAsync((char*)d_ws + WS_CTL, 0, 65536, stream) != hipSuccess) { fprintf(stderr, "kernel_launch: hipMemsetAsync failed\n"); return; }
    Args a{};
    for (int i = 0; i < 23; ++i) a.p.in[i] = (const float*)d_in[i];
    a.p.out = (float*)d_out; a.p.ws = (unsigned char*)d_ws;
#if MK_MULTI
#ifdef DBG_DUMP
    for (int k = 0; k <= DBG_LAST; ++k) { a.ph_lo = k; a.ph_hi = k + 1; hipLaunchKernelGGL(fwd, dim3(grid), dim3(512), LDS_BYTES, stream, a); }
    a.ph_lo = NPH; a.ph_hi = NPH + 1; hipLaunchKernelGGL(fwd, dim3(grid), dim3(512), LDS_BYTES, stream, a);
#else
    for (int k = 0; k < NPH; ++k) { a.ph_lo = k; a.ph_hi = k + 1; hipLaunchKernelGGL(fwd, dim3(grid), dim3(512), LDS_BYTES, stream, a); }
#endif
#else
    a.ph_lo = 0; a.ph_hi = NPH;
    void* args[] = {&a};
    hipError_t e = hipLaunchCooperativeKernel((const void*)fwd, dim3(grid), dim3(512), args, LDS_BYTES, stream);
    if (e != hipSuccess) fprintf(stderr, "cooperative launch failed: %s (grid %d)\n", hipGetErrorString(e), grid);
#endif
}
```

```cpp
#include <hip/hip_runtime.h>
#include <hip/hip_cooperative_groups.h>
#include <cstdio>
#include <cstdint>
namespace cg = cooperative_groups;
#ifndef MK_MULTI
#define MK_MULTI 0
#endif
namespace pg8 {
#define PG8_LAS __attribute__((address_space(3)))
typedef unsigned short bf16_t;
typedef short bf16x8 __attribute__((ext_vector_type(8)));
typedef float f32x4 __attribute__((ext_vector_type(4)));
typedef unsigned u32x4 __attribute__((ext_vector_type(4)));
constexpr int BM = 256, BK = 64, HALF = 128, HTB = HALF * BK * 2  , STAGE_BYTES = 8 * HTB, NXCD = 8, WGM = 8;

__host__ __device__ __forceinline__ int lds_byte(int r, int c) { const int st = (r >> 4) * 2 + (c >> 5), rr = r & 15, cc = c & 31, ob = rr * 64 + cc * 2; return st * 1024 + (ob ^ (((ob >> 9) & 1) << 5)); }
__host__ __device__ __forceinline__ void stage_rc(int b, int& R, int& C) { const int st = b / 1024, sb = b % 1024, swz = sb ^ (((sb >> 9) & 1) << 5); R = (st >> 1) * 16 + swz / 64; C = (st & 1) * 32 + (swz % 64) / 2; }
__host__ __device__ __forceinline__ int perm32(int rho) { const int n = rho >> 4, i = rho & 15; return 8 * (i >> 2) + 4 * n + (i & 3); }

struct Unit { int pm, pn; };
struct Gemm { const bf16_t* A; const bf16_t* Bt; int M, N, K; };

struct StaticOrder {
    int nM, nN, nwg, G, c;
    __host__ __device__ void init(int M, int N, int G_, int c_) { nM = M / BM; nN = N / BM; nwg = nM * nN; G = G_; c = c_; }
    __host__ __device__ bool next(int i, Unit& u) const {
        const long L = (long)i * G + c; if (L >= nwg) return false;
        int wgid = (int)L; { const int q = nwg / NXCD, r = nwg % NXCD, xcd = wgid % NXCD, off = wgid / NXCD; wgid = (xcd < r ? xcd * (q + 1) : r * (q + 1) + (xcd - r) * q) + off; }
        const int nig = WGM * nN, gid = wgid / nig, fm = gid * WGM, gsz = (nM - fm) < WGM ? (nM - fm) : WGM;
        u.pm = fm + ((wgid % nig) % gsz); u.pn = (wgid % nig) / gsz; return true;
    }
    __device__ __forceinline__ void a_ready(const Unit&) const {}
    __device__ __forceinline__ void done(const Unit&) const {}
};
struct OneUnit {
    int pm, pn;
    __host__ __device__ bool next(int i, Unit& u) const { if (i != 0) return false; u.pm = pm; u.pn = pn; return true; }
    __device__ __forceinline__ void a_ready(const Unit&) const {}
    __device__ __forceinline__ void done(const Unit&) const {}
};
__device__ __forceinline__ unsigned cvt_pk_bf16(float lo, float hi) { unsigned r; asm volatile("v_cvt_pk_bf16_f32 %0, %1, %2" : "=v"(r) : "v"(lo), "v"(hi)); return r; }
template <int ACT, bool RS> struct EpiStore {
    static constexpr bool PERM = true, AFTER_DRAIN = false;
    bf16_t* O; int ldc; const float* ssq;
    __device__ __forceinline__ void pre(float (&rsv)[8], const Unit& u, int wr, int fr) const {
        if (RS) {
#pragma unroll
            for (int ai = 0; ai < 2; ++ai)
#pragma unroll
                for (int m = 0; m < 4; ++m) rsv[ai * 4 + m] = ssq[u.pm * BM + wr * 64 + fr + ai * HALF + m * 16];
        }
    }
    __device__ __forceinline__ void operator()(const f32x4 (&acc)[2][2][4][2], const float (&rsv)[8], const Unit& u, int wr, int wc, int fr, int fq) const {
        const int row0 = u.pm * BM + wr * 64 + fr, col0 = u.pn * BM + wc * 32 + 8 * fq;
#pragma unroll
        for (int ai = 0; ai < 2; ++ai)
#pragma unroll
            for (int m = 0; m < 4; ++m) {
                const int row = row0 + ai * HALF + m * 16;
                float rs = 1.f; if (RS) rs = rsqrtf(rsv[ai * 4 + m] * (1.0f / 1024.0f) + 1e-6f);
                bf16_t* rowp = O + (size_t)row * ldc + col0;
#pragma unroll
                for (int bj = 0; bj < 2; ++bj) {
                    f32x4 v0 = acc[ai][bj][m][0] * rs, v1 = acc[ai][bj][m][1] * rs;
                    if (ACT == 2) {
#pragma unroll
                        for (int e = 0; e < 4; ++e) { float a = fmaxf(v0[e], 0.f), b = fmaxf(v1[e], 0.f); v0[e] = a * a; v1[e] = b * b; }
                    }
                    u32x4 w; w.x = cvt_pk_bf16(v0[0], v0[1]); w.y = cvt_pk_bf16(v0[2], v0[3]); w.z = cvt_pk_bf16(v1[0], v1[1]); w.w = cvt_pk_bf16(v1[2], v1[3]);
                    *(u32x4*)(rowp + bj * HALF) = w;
                }
            }
    }
};
template <bool BASE_BF16, bool OUT_F32> struct EpiRes {
    static constexpr bool PERM = true, AFTER_DRAIN = false;
    const void* base; float* out; bf16_t* xb; float* ssq;
    __device__ __forceinline__ void pre(float (&rsv)[8], const Unit&, int, int) const {}
    __device__ __forceinline__ void operator()(const f32x4 (&acc)[2][2][4][2], const float (&rsv)[8], const Unit& u, int wr, int wc, int fr, int fq) const {
        const int row0 = u.pm * BM + wr * 64 + fr, col0 = u.pn * BM + wc * 32 + 8 * fq;
#pragma unroll
        for (int ai = 0; ai < 2; ++ai)
#pragma unroll
            for (int m = 0; m < 4; ++m) {
                const int row = row0 + ai * HALF + m * 16; float s = 0.f;
#pragma unroll
                for (int bj = 0; bj < 2; ++bj) {
                    const size_t off = (size_t)row * 1024 + col0 + bj * HALF;
                    f32x4 b0, b1;
                    if (BASE_BF16) { const u32x4 r = *(const u32x4*)((const bf16_t*)base + off);
                        b0 = (f32x4){__uint_as_float(r.x << 16), __uint_as_float(r.x & 0xffff0000u), __uint_as_float(r.y << 16), __uint_as_float(r.y & 0xffff0000u)};
                        b1 = (f32x4){__uint_as_float(r.z << 16), __uint_as_float(r.z & 0xffff0000u), __uint_as_float(r.w << 16), __uint_as_float(r.w & 0xffff0000u)}; }
                    else { b0 = *(const f32x4*)((const float*)base + off); b1 = *(const f32x4*)((const float*)base + off + 4); }
                    const f32x4 v0 = acc[ai][bj][m][0] + b0, v1 = acc[ai][bj][m][1] + b1;
                    if (OUT_F32) { *(f32x4*)(out + off) = v0; *(f32x4*)(out + off + 4) = v1; }
                    else {
                        u32x4 w; w.x = cvt_pk_bf16(v0[0], v0[1]); w.y = cvt_pk_bf16(v0[2], v0[3]); w.z = cvt_pk_bf16(v1[0], v1[1]); w.w = cvt_pk_bf16(v1[2], v1[3]); *(u32x4*)(xb + off) = w;
                        s += (v0[0] * v0[0] + v0[1] * v0[1]) + (v0[2] * v0[2] + v0[3] * v0[3]) + (v1[0] * v1[0] + v1[1] * v1[1]) + (v1[2] * v1[2] + v1[3] * v1[3]);
                    }
                }
                if (!OUT_F32) { s += __shfl_xor(s, 16); s += __shfl_xor(s, 32); if (fq == 0) atomicAdd(ssq + row, s); }
            }
    }
};

template <class Epi, class Sched, bool ALIGN_EPI = false, bool SP2 = false>
__device__ __forceinline__ void gemm_phase(PG8_LAS unsigned char* lds, const Gemm g, const Sched& S, const Epi& E) {
    const int tid = threadIdx.x, wid = __builtin_amdgcn_readfirstlane(tid >> 6), lane = tid & 63, wr = wid >> 2, wc = wid & 3, fr = lane & 15, fq = lane >> 4;
    const int K = g.K, nt = K / BK;
    unsigned voffA[2], voffB[2];
#pragma unroll
    for (int i = 0; i < 2; ++i) { int R, C; stage_rc(tid * 16 + i * 8192, R, C); const int Rb = Epi::PERM ? ((R & ~31) + perm32(R & 31)) : R;
        voffA[i] = (unsigned)(R * K + C) * 2u; voffB[i] = (unsigned)(Rb * K + C) * 2u; }
    const size_t kstep = (size_t)(BK * 2);
    const size_t hstep = (size_t)HALF * K * 2;
    const size_t tstep = 2 * hstep;
    const unsigned ldsw = (unsigned)wid * 1024u;
    const int aoff = lds_byte(wr * 64 + fr, fq * 8), boff = lds_byte(wc * 32 + fr, fq * 8);
#define PG8_SA(b, h) (((b) * 2 + (h)) * HTB)
#define PG8_SB(b, h) ((4 + (b) * 2 + (h)) * HTB)
#define PG8_STAGE(bufoff, gbase, voff) do { _Pragma("unroll") for (int _i = 0; _i < 2; ++_i) \
        __builtin_amdgcn_global_load_lds((const unsigned*)((const char*)(gbase) + (voff)[_i]), (PG8_LAS unsigned*)(lds + (bufoff) + ldsw + _i * 8192), 16, 0, 0); } while (0)
#define PG8_LDA(dst, b, h) do { _Pragma("unroll") for (int m = 0; m < 4; ++m) _Pragma("unroll") for (int k = 0; k < 2; ++k) dst[m][k] = *(const PG8_LAS bf16x8*)(lds + PG8_SA(b, h) + aoff + m * 2048 + k * 1024); } while (0)
#define PG8_LDB(dst, b, h) do { _Pragma("unroll") for (int n = 0; n < 2; ++n) _Pragma("unroll") for (int k = 0; k < 2; ++k) dst[n][k] = *(const PG8_LAS bf16x8*)(lds + PG8_SB(b, h) + boff + n * 2048 + k * 1024); } while (0)
#define PG8_MMA(ai, bj, At, Bt) do { __builtin_amdgcn_s_setprio(1); _Pragma("unroll") for (int m = 0; m < 4; ++m) _Pragma("unroll") for (int n = 0; n < 2; ++n) _Pragma("unroll") for (int k = 0; k < 2; ++k) \
        acc[ai][bj][m][n] = __builtin_amdgcn_mfma_f32_16x16x32_bf16(Bt[n][k], At[m][k], acc[ai][bj][m][n], 0, 0, 0); __builtin_amdgcn_s_setprio(0); } while (0)
#define PG8_WAIT_V(n) asm volatile("s_waitcnt vmcnt(" #n ")" ::: "memory")
#define PG8_WAIT_L(n) asm volatile("s_waitcnt lgkmcnt(" #n ")" ::: "memory")
#define PG8_BAR __builtin_amdgcn_s_barrier()
#define PG8_SCHED __builtin_amdgcn_sched_barrier(0)
    Unit cur, nxt; int ui = 0;
    if (!S.next(0, cur)) return;
    f32x4 acc[2][2][4][2];
#pragma unroll
    for (int a = 0; a < 2; ++a)
#pragma unroll
        for (int b = 0; b < 2; ++b)
#pragma unroll
            for (int m = 0; m < 4; ++m)
#pragma unroll
                for (int n = 0; n < 2; ++n) acc[a][b][m][n] = (f32x4){0.f, 0.f, 0.f, 0.f};
    bf16x8 At[4][2], B0[2][2], B1[2][2];
    const char* cA = (const char*)g.A + (size_t)cur.pm * tstep; const char* cB = (const char*)g.Bt + (size_t)cur.pn * tstep;
    S.a_ready(cur);
    if constexpr (SP2) {
        PG8_STAGE(PG8_SB(0, 0), cB, voffB); PG8_STAGE(PG8_SB(0, 1), cB + hstep, voffB); PG8_STAGE(PG8_SA(0, 0), cA, voffA); PG8_STAGE(PG8_SA(0, 1), cA + hstep, voffA);
        if (wr == 1) PG8_BAR;
        PG8_WAIT_V(2); PG8_BAR;
        PG8_STAGE(PG8_SB(1, 0), cB + kstep, voffB); PG8_STAGE(PG8_SA(1, 0), cA + kstep, voffA); PG8_STAGE(PG8_SB(1, 1), cB + hstep + kstep, voffB);
        PG8_WAIT_V(6); PG8_BAR;
    } else {
        PG8_STAGE(PG8_SB(0, 0), cB, voffB); PG8_STAGE(PG8_SA(0, 0), cA, voffA); PG8_STAGE(PG8_SB(0, 1), cB + hstep, voffB); PG8_STAGE(PG8_SA(0, 1), cA + hstep, voffA);
        if (wr == 1) PG8_BAR;
        PG8_WAIT_V(4); PG8_BAR;
        PG8_STAGE(PG8_SB(1, 0), cB + kstep, voffB); PG8_STAGE(PG8_SA(1, 0), cA + kstep, voffA); PG8_STAGE(PG8_SB(1, 1), cB + hstep + kstep, voffB);
        PG8_WAIT_V(6); PG8_BAR;
    }
    float rsv[8];
    for (;;) {
        const bool has_next = S.next(ui + 1, nxt);
        E.pre(rsv, cur, wr, fr);
        const char* nA = has_next ? (const char*)g.A + (size_t)nxt.pm * tstep : cA; const char* nB = has_next ? (const char*)g.Bt + (size_t)nxt.pn * tstep : cB;
        for (int t = 0; t < nt; t += 2) {
            const bool last = (t == nt - 2);
            const char* a1 = cA + (size_t)(t + 1) * kstep;
            const char* a2 = last ? nA : cA + (size_t)(t + 2) * kstep; const char* b2 = last ? nB : cB + (size_t)(t + 2) * kstep;
            const char* a3 = a2 + kstep; const char* b3 = b2 + kstep;
            if (last && has_next) S.a_ready(nxt);
            if constexpr (SP2) {
            PG8_LDB(B0, 0, 0); PG8_LDB(B1, 0, 1); PG8_SCHED; PG8_LDA(At, 0, 0); PG8_STAGE(PG8_SA(1, 1), a1 + hstep, voffA);
            PG8_WAIT_V(8); PG8_WAIT_L(0); PG8_BAR; PG8_MMA(0, 0, At, B0); PG8_MMA(0, 1, At, B1); PG8_BAR; PG8_SCHED;
            PG8_LDA(At, 0, 1); PG8_STAGE(PG8_SB(0, 0), b2, voffB); PG8_STAGE(PG8_SB(0, 1), b2 + hstep, voffB); PG8_STAGE(PG8_SA(0, 0), a2, voffA);
            PG8_WAIT_V(8); PG8_WAIT_L(0); PG8_BAR; PG8_MMA(1, 0, At, B0); PG8_MMA(1, 1, At, B1); PG8_BAR; PG8_SCHED;
            PG8_LDB(B0, 1, 0); PG8_LDB(B1, 1, 1); PG8_SCHED; PG8_LDA(At, 1, 0); PG8_STAGE(PG8_SA(0, 1), a2 + hstep, voffA);
            PG8_WAIT_V(8); PG8_WAIT_L(0); PG8_BAR; PG8_MMA(0, 0, At, B0); PG8_MMA(0, 1, At, B1); PG8_BAR; PG8_SCHED;
            PG8_LDA(At, 1, 1); PG8_STAGE(PG8_SB(1, 0), b3, voffB); PG8_STAGE(PG8_SB(1, 1), b3 + hstep, voffB); PG8_STAGE(PG8_SA(1, 0), a3, voffA);
            PG8_WAIT_V(8); PG8_WAIT_L(0); PG8_BAR; PG8_MMA(1, 0, At, B0); PG8_MMA(1, 1, At, B1); PG8_BAR; PG8_SCHED;
            } else {
            PG8_LDB(B0, 0, 0); PG8_SCHED; PG8_LDA(At, 0, 0); PG8_STAGE(PG8_SA(1, 1), a1 + hstep, voffA);
            PG8_WAIT_L(8); PG8_BAR; PG8_WAIT_L(0); PG8_MMA(0, 0, At, B0); PG8_BAR; PG8_SCHED;
            PG8_LDB(B1, 0, 1); PG8_STAGE(PG8_SB(0, 0), b2, voffB);
            PG8_BAR; PG8_WAIT_L(0); PG8_MMA(0, 1, At, B1); PG8_BAR;
            PG8_LDA(At, 0, 1); PG8_STAGE(PG8_SA(0, 0), a2, voffA);
            PG8_BAR; PG8_WAIT_L(0); PG8_MMA(1, 0, At, B0); PG8_BAR; PG8_SCHED;
            PG8_STAGE(PG8_SB(0, 1), b2 + hstep, voffB);
            PG8_WAIT_V(6); PG8_BAR; PG8_MMA(1, 1, At, B1); PG8_BAR;
            PG8_LDB(B0, 1, 0); PG8_SCHED; PG8_LDA(At, 1, 0); PG8_STAGE(PG8_SA(0, 1), a2 + hstep, voffA);
            PG8_WAIT_L(8); PG8_BAR; PG8_WAIT_L(0); PG8_MMA(0, 0, At, B0); PG8_BAR; PG8_SCHED;
            PG8_LDB(B1, 1, 1); PG8_STAGE(PG8_SB(1, 0), b3, voffB);
            PG8_BAR; PG8_WAIT_L(0); PG8_MMA(0, 1, At, B1); PG8_BAR;
            PG8_LDA(At, 1, 1); PG8_STAGE(PG8_SA(1, 0), a3, voffA);
            PG8_BAR; PG8_WAIT_L(0); PG8_MMA(1, 0, At, B0); PG8_BAR; PG8_SCHED;
            PG8_STAGE(PG8_SB(1, 1), b3 + hstep, voffB);
            PG8_WAIT_V(6); PG8_BAR; PG8_MMA(1, 1, At, B1); PG8_BAR;
            }
        }
        if constexpr (ALIGN_EPI) { if (wr == 0) PG8_BAR; }
        if constexpr (!Epi::AFTER_DRAIN) { E(acc, rsv, cur, wr, wc, fr, fq); S.done(cur); }
        if (!has_next) break;
#pragma unroll
        for (int a = 0; a < 2; ++a)
#pragma unroll
            for (int b = 0; b < 2; ++b)
#pragma unroll
                for (int m = 0; m < 4; ++m)
#pragma unroll
                    for (int n = 0; n < 2; ++n) acc[a][b][m][n] = (f32x4){0.f, 0.f, 0.f, 0.f};
        cur = nxt; cA = nA; cB = nB; ++ui;
        if constexpr (ALIGN_EPI) { if (wr == 1) PG8_BAR; }
    }
    PG8_WAIT_V(0);
    if constexpr (!ALIGN_EPI) { if (wr == 0) PG8_BAR; }
    PG8_BAR;
    if constexpr (Epi::AFTER_DRAIN) { E.fused(acc, cur, wr, wc, fr, fq, lds, wid, lane); S.done(cur); }
#undef PG8_SA
#undef PG8_SB
#undef PG8_STAGE
#undef PG8_LDA
#undef PG8_LDB
#undef PG8_MMA
#undef PG8_WAIT_V
#undef PG8_WAIT_L
#undef PG8_BAR
#undef PG8_SCHED
}
}
#define LAS __attribute__((address_space(3)))
typedef unsigned short bf16;
typedef short bf16x8 __attribute__((ext_vector_type(8)));
typedef short s16x4 __attribute__((ext_vector_type(4)));
typedef float f32x4 __attribute__((ext_vector_type(4)));
typedef float f32x16 __attribute__((ext_vector_type(16)));
typedef unsigned u32x4 __attribute__((ext_vector_type(4)));
typedef unsigned u32x2 __attribute__((ext_vector_type(2)));
typedef LAS unsigned char* lptr;
constexpr int NT = 32768, DM = 1024, SEQ = 2048, NB = 16, NPROJ = 3584, DFF = 4096, MEMR = 4096;
constexpr float EPS = 1e-6f, LOG2E = 1.4426950408889634f;
constexpr size_t MiB = 1u << 20;
constexpr size_t WS_CTL = 0, WS_BARW = 16384, WS_SSQ1 = 1 * MiB, WS_SSQ2 = 1 * MiB + 131072, WS_GATES = 2 * MiB, WS_CK = 4 * MiB, WS_GL = 5 * MiB;
constexpr size_t WS_WIN = 6 * MiB, WS_WOUT = 13 * MiB, WS_WCQ = 15 * MiB, WS_WCKV = 16 * MiB, WS_WCO = 18 * MiB, WS_W1 = 19 * MiB, WS_W2 = 27 * MiB;
constexpr size_t WS_HM = 35 * MiB, WS_CKV = 43 * MiB, WS_BUFA = 52 * MiB, WS_BIG = 116 * MiB;
constexpr size_t WS_PROJ = WS_BIG, WS_GP = WS_BIG + 224 * MiB, WS_XB1 = WS_BIG, WS_CQ = WS_BIG + 64 * MiB, WS_CO = WS_BIG + 96 * MiB, WS_HMID = WS_BIG;
constexpr size_t WS_END = WS_GP + 144 * MiB;
constexpr int GP_CHUNK = 73728, GP_W = 0, GP_QG = 16384, GP_KDT = 32768, GP_UT = 49152, GP_IN = 65536;
constexpr int LDS_BYTES = 147456, LDS_MISC = LDS_BYTES - 64;
constexpr int NPH = 10;

__device__ __forceinline__ float bflo(unsigned u) { return __uint_as_float(u << 16); }
__device__ __forceinline__ float bfhi(unsigned u) { return __uint_as_float(u & 0xffff0000u); }
typedef float f32x2_t __attribute__((ext_vector_type(2))); typedef __bf16 bf16x2_t __attribute__((ext_vector_type(2)));
__device__ __forceinline__ unsigned pk2(float lo, float hi) { f32x2_t v = {lo, hi}; bf16x2_t b = __builtin_convertvector(v, bf16x2_t); return __builtin_bit_cast(unsigned, b); }
__device__ __forceinline__ unsigned pk2v(float lo, float hi) { return pg8::cvt_pk_bf16(lo, hi); }
__device__ __forceinline__ f32x4 mfma16(bf16x8 a, bf16x8 b, f32x4 c) { return __builtin_amdgcn_mfma_f32_16x16x32_bf16(a, b, c, 0, 0, 0); }
__device__ __forceinline__ f32x16 mfma32(bf16x8 a, bf16x8 b, f32x16 c) { return __builtin_amdgcn_mfma_f32_32x32x16_bf16(a, b, c, 0, 0, 0); }
__device__ __forceinline__ bf16x8 lds8(lptr p) { return *(const LAS bf16x8*)p; }
typedef short v4i16_t __attribute__((ext_vector_type(4)));
__device__ __forceinline__ s16x4 vtr(lptr pv) { return __builtin_bit_cast(s16x4, __builtin_amdgcn_ds_read_tr16_b64_v4i16((LAS v4i16_t*)pv)); }
template <int CTRL> __device__ __forceinline__ float dpp_add(float v) { const int t = __builtin_amdgcn_update_dpp(0, __builtin_bit_cast(int, v), CTRL, 0xf, 0xf, true); return v + __builtin_bit_cast(float, t); }
__device__ __forceinline__ float row8_sum(float v) { v = dpp_add<0xB1>(v); v = dpp_add<0x4E>(v); v = dpp_add<0x141>(v); return v; }
__device__ __forceinline__ float row16_sum(float v) { v = row8_sum(v); v = dpp_add<0x140>(v); return v; }
__device__ __forceinline__ float rdl(float v, int l) { return __builtin_bit_cast(float, __builtin_amdgcn_readlane(__builtin_bit_cast(int, v), l)); }
__device__ __forceinline__ float wave_sum(float v) { v = row16_sum(v); return (rdl(v, 0) + rdl(v, 16)) + (rdl(v, 32) + rdl(v, 48)); }
__device__ __forceinline__ float xor32(float v) { const auto r = __builtin_amdgcn_permlane32_swap(__float_as_uint(v), __float_as_uint(v), false, false); return (threadIdx.x & 32) ? __uint_as_float(r[0]) : __uint_as_float(r[1]); }
#define LDS_WAIT() asm volatile("s_waitcnt lgkmcnt(0)" ::: "memory")
__device__ __forceinline__ float siluf(float y) { return y * __builtin_amdgcn_rcpf(1.f + __expf(-y)); }
__device__ __forceinline__ float softplusf(float z) { return fmaxf(z, 0.f) + log1pf(__expf(-fabsf(z))); }

__device__ __forceinline__ void transpose_item(const float* W, int K, int Ntot, int col0, int ncols, bf16* WT, int row_off, const float* gain, LAS float* scr, int item, int lane) {
    const int nblk = ncols / 32, kb = item / nblk, nb = item % nblk, k0 = 64 * kb, n0 = 32 * nb;
#pragma unroll
    for (int i = 0; i < 32; ++i) { const int kk = 2 * i + (lane >> 5); float v = W[(size_t)(k0 + kk) * Ntot + col0 + n0 + (lane & 31)]; if (gain) v *= gain[k0 + kk]; scr[kk * 33 + (lane & 31)] = v; }
    LDS_WAIT();
    const int c = lane & 7;
#pragma unroll
    for (int j = 0; j < 4; ++j) { const int n = (lane >> 3) + 8 * j; const LAS float* s = scr + (8 * c) * 33 + n;
        u32x4 o; o.x = pk2v(s[0 * 33], s[1 * 33]); o.y = pk2v(s[2 * 33], s[3 * 33]); o.z = pk2v(s[4 * 33], s[5 * 33]); o.w = pk2v(s[6 * 33], s[7 * 33]);
        *(u32x4*)(WT + (size_t)(row_off + n0 + n) * K + k0 + 8 * c) = o; }
    LDS_WAIT();
}
struct P { const float* in[23]; float* out; unsigned char* ws; };

template <bool GATES>
__device__ __forceinline__ void norm_row(const P& p, f32x4 (&v)[4], const float* g, bf16* orow, float* gates_row, const LAS float* w16, int lane) {
    const f32x4* gr = (const f32x4*)g + lane;
    float s = 0.f;
#pragma unroll
    for (int j = 0; j < 4; ++j) { s += (v[j].x * v[j].x + v[j].y * v[j].y) + (v[j].z * v[j].z + v[j].w * v[j].w); }
    const float rstd = rsqrtf(wave_sum(s) * (1.f / DM) + EPS);
    unsigned long long* o8 = (unsigned long long*)orow + lane;
#pragma unroll
    for (int j = 0; j < 4; ++j) { v[j] = v[j] * rstd * gr[64 * j]; o8[64 * j] = (unsigned long long)pk2v(v[j].x, v[j].y) | ((unsigned long long)pk2v(v[j].z, v[j].w) << 32); }
    if (GATES) {
        float mine = 0.f;
#pragma unroll
        for (int c4 = 0; c4 < 4; ++c4) {
            f32x4 w4[4][4];
#pragma unroll
            for (int cc = 0; cc < 4; ++cc)
#pragma unroll
                for (int j = 0; j < 4; ++j) w4[cc][j] = *(const LAS f32x4*)(w16 + (4 * c4 + cc) * 1024 + 256 * j + 4 * lane);
            __builtin_amdgcn_sched_barrier(0);
#pragma unroll
            for (int cc = 0; cc < 4; ++cc) {
                float d = 0.f;
#pragma unroll
                for (int j = 0; j < 4; ++j) d += (v[j].x * w4[cc][j].x + v[j].y * w4[cc][j].y) + (v[j].z * w4[cc][j].z + v[j].w * w4[cc][j].w);
                d = wave_sum(d);
                mine = (lane == 4 * c4 + cc) ? d : mine;
            }
        }
        if (lane < 16) {
            float r;
            if (lane < 8) { const float z = mine + p.in[6][lane]; r = -softplusf(-z); }
            else if (lane < 12) { r = 1.f / (1.f + __expf(-mine)); }
            else { r = -__expf(p.in[9][lane - 12]) * softplusf(mine + p.in[10][lane - 12]); }
            gates_row[lane] = r;
        }
    }
}

constexpr int LATE_ITEMS = 16 * 32 + 16 * 16 + 8 * 32 + 16 * 128 + 64 * 32;
__device__ __forceinline__ void late_transpose_item(const P& p, LAS float* scr, int r, int lane) {
    unsigned char* ws = p.ws;
    constexpr int I3 = 16 * 32, I4 = 16 * 16, I6 = 8 * 32, I7 = 16 * 128;
    if (r < I3) { transpose_item(p.in[12], 1024, 1024, 0, 1024, (bf16*)(ws + WS_WOUT), 0, nullptr, scr, r, lane); return; } r -= I3;
    if (r < I4) { transpose_item(p.in[15], 1024, 512, 0, 512, (bf16*)(ws + WS_WCQ), 0, p.in[13], scr, r, lane); return; } r -= I4;
    if (r < I6) { transpose_item(p.in[19], 512, 1024, 0, 1024, (bf16*)(ws + WS_WCO), 0, nullptr, scr, r, lane); return; } r -= I6;
    if (r < I7) { transpose_item(p.in[21], 1024, 4096, 0, 4096, (bf16*)(ws + WS_W1), 0, p.in[20], scr, r, lane); return; } r -= I7;
    transpose_item(p.in[22], 4096, 1024, 0, 1024, (bf16*)(ws + WS_W2), 0, nullptr, scr, r, lane);
}

__device__ __forceinline__ void p0_prologue(const P& p, lptr lds, int G) {
    const int tid = threadIdx.x, lane = tid & 63, wave = tid >> 6;
    const int gw = blockIdx.x * 8 + wave, NGW = G * 8;
    unsigned char* ws = p.ws;
    for (int i = blockIdx.x * 512 + tid; i < 2 * NT; i += G * 512) ((float*)(ws + WS_SSQ1))[i] = 0.f;
    if (blockIdx.x == 0 && tid < 64) ((unsigned*)(ws + WS_CTL))[tid] = 0u;
    LAS float* w16 = (LAS float*)lds;
    {
        float wv[32];
#pragma unroll
        for (int u = 0; u < 32; ++u) { const int i = tid + 512 * u, k = i >> 4, c = i & 15; const int col = c < 8 ? 1536 + c : 3072 + c; wv[u] = p.in[3][(size_t)k * 3600 + col]; }
#pragma unroll
        for (int u = 0; u < 32; ++u) { const int i = tid + 512 * u, k = i >> 4, c = i & 15; *(LAS bf16*)(lds + c * 2064 + k * 2) = (bf16)(pk2v(wv[u], 0.f) & 0xffffu); }
    }
    __syncthreads();
    {
        const lptr tile = lds + 65536 + wave * 8448;
        const int fr = lane & 15, fg = lane >> 4;
        f32x4 gq[4];
#pragma unroll
        for (int j = 0; j < 4; ++j) gq[j] = ((const f32x4*)p.in[2] + lane)[64 * j];
        const int nrow = (NT - gw + NGW - 1) / NGW;
        const int gty = fr < 8 ? 0 : (fr < 12 ? 1 : 2);
        const float gadd = (gty == 0) ? p.in[6][fr & 7] : ((gty == 2) ? p.in[10][fr & 3] : 0.f);
        const float gA = -__expf(p.in[9][fr & 3]);
        f32x4 cur[4][4];
#pragma unroll
        for (int q = 0; q < 4; ++q) if (q < nrow) {
#pragma unroll
            for (int j = 0; j < 4; ++j) cur[q][j] = ((const f32x4*)(p.in[0] + (size_t)(gw + q * NGW) * DM) + lane)[64 * j];
        }
        for (int i0 = 0; i0 < nrow; i0 += 4) {
#pragma unroll
            for (int q = 0; q < 4; ++q) if (i0 + q < nrow) {
                const int m = gw + (i0 + q) * NGW;
                float ssum = 0.f;
#pragma unroll
                for (int j = 0; j < 4; ++j) ssum += (cur[q][j].x * cur[q][j].x + cur[q][j].y * cur[q][j].y) + (cur[q][j].z * cur[q][j].z + cur[q][j].w * cur[q][j].w);
                const float rstd = rsqrtf(wave_sum(ssum) * (1.f / DM) + EPS);
                unsigned long long* o8 = (unsigned long long*)((bf16*)(ws + WS_BUFA) + (size_t)m * DM) + lane;
#pragma unroll
                for (int j = 0; j < 4; ++j) { const f32x4 v = cur[q][j] * rstd * gq[j];
                    const unsigned long long w = (unsigned long long)pk2v(v.x, v.y) | ((unsigned long long)pk2v(v.z, v.w) << 32);
                    o8[64 * j] = w; *(LAS unsigned long long*)(tile + q * 2064 + (256 * j + 4 * lane) * 2) = w; }
            }
#pragma unroll
            for (int q = 0; q < 4; ++q) if (i0 + 4 + q < nrow) {
#pragma unroll
                for (int j = 0; j < 4; ++j) cur[q][j] = ((const f32x4*)(p.in[0] + (size_t)(gw + (i0 + 4 + q) * NGW) * DM) + lane)[64 * j];
            }
            LDS_WAIT();
            f32x4 acc = (f32x4){0.f, 0.f, 0.f, 0.f};
#pragma unroll
            for (int kb = 0; kb < 4; ++kb) {
                bf16x8 af[8], bfr[8];
#pragma unroll
                for (int k8 = 0; k8 < 8; ++k8) { const int kk = 8 * kb + k8; af[k8] = lds8(tile + (fr & 3) * 2064 + (32 * kk + 8 * fg) * 2); bfr[k8] = lds8(lds + fr * 2064 + (32 * kk + 8 * fg) * 2); }
                __builtin_amdgcn_sched_barrier(0);
#pragma unroll
                for (int k8 = 0; k8 < 8; ++k8) acc = mfma16(af[k8], bfr[k8], acc);
                __builtin_amdgcn_sched_barrier(0);
            }
            if (fg == 0) {
#pragma unroll
                for (int e = 0; e < 4; ++e) if (i0 + e < nrow) {
                    const float z = acc[e] + gadd, ex = __expf(-fabsf(z)), den = 1.f + ex, l = __logf(den), r = __builtin_amdgcn_rcpf(den);
                    const float spp = fmaxf(z, 0.f) + l, spn = fmaxf(-z, 0.f) + l, sg = (z >= 0.f) ? r : ex * r;
                    const float o = (gty == 0) ? -spn : ((gty == 1) ? sg : gA * spp);
                    ((float*)(ws + WS_GATES))[(size_t)(gw + (i0 + e) * NGW) * 16 + fr] = o;
                }
            }
            LDS_WAIT();
        }
        if (G != 256) {
#pragma unroll
        for (int q = 0; q < 4; ++q) if (gw + q * NGW < MEMR) {
#pragma unroll
            for (int j = 0; j < 4; ++j) cur[q][j] = ((const f32x4*)(p.in[1] + (size_t)(gw + q * NGW) * DM) + lane)[64 * j];
        }
#pragma unroll
        for (int q = 0; q < 4; ++q) if (gw + q * NGW < MEMR) norm_row<false>(p, cur[q], p.in[14], (bf16*)(ws + WS_HM) + (size_t)(gw + q * NGW) * DM, nullptr, w16, lane);
        for (int m = gw + 4 * NGW; m < MEMR; m += NGW) {
#pragma unroll
            for (int j = 0; j < 4; ++j) cur[0][j] = ((const f32x4*)(p.in[1] + (size_t)m * DM) + lane)[64 * j];
            norm_row<false>(p, cur[0], p.in[14], (bf16*)(ws + WS_HM) + (size_t)m * DM, nullptr, w16, lane);
        }
        }
    }
    LAS float* scr = (LAS float*)(lds + 65536 + wave * 8448);
    constexpr int I0 = 16 * 48, I1 = 16 * 48, I2 = 16 * 16, I3 = 16 * 32, I4 = 16 * 16, I5 = 16 * 32, I6 = 8 * 32, I7 = 16 * 128, I8 = 64 * 32;
    constexpr int NITEMS = I0 + I1 + I2 + I3 + I4 + I5 + I6 + I7 + I8;
    for (int it = gw; it < I0 + I1 + I2 + I5; it += NGW) {
        int r = it;
        if (r < I0) { transpose_item(p.in[3], 1024, 3600, 0, 1536, (bf16*)(ws + WS_WIN), 0, nullptr, scr, r, lane); continue; } r -= I0;
        if (r < I1) { transpose_item(p.in[3], 1024, 3600, 1544, 1536, (bf16*)(ws + WS_WIN), 1536, nullptr, scr, r, lane); continue; } r -= I1;
        if (r < I2) { transpose_item(p.in[3], 1024, 3600, 3088, 512, (bf16*)(ws + WS_WIN), 3072, nullptr, scr, r, lane); continue; } r -= I2;
        transpose_item(p.in[16], 1024, 1024, 0, 1024, (bf16*)(ws + WS_WCKV), 0, nullptr, scr, r, lane);
    }
    __syncthreads();
}
constexpr int PQ_KN = 0, PQ_V = 17408, PQ_QS = 34816, PQ_TB = 34816, PQ_TW = 44032, PQ_LM = 53248, PQ_GC = 69632, PQ_BETA = 69888, PQ_STREAM = 70144;

template <int GLN>
__device__ __forceinline__ void knorm_rows8(bf16* base, size_t pitch, int m0, int mstride, int mend, const float* gain, int lane) {
    const float* gp = gain + (lane & (GLN - 1)) * 8;
    const f32x4 g0 = *(const f32x4*)gp, g1 = *(const f32x4*)(gp + 4);
    u32x4 raw[8];
#pragma unroll
    for (int u = 0; u < 8; ++u) { const int m = m0 + u * mstride; raw[u] = (u32x4){0u, 0u, 0u, 0u}; if (m < mend) raw[u] = *(const u32x4*)(base + (size_t)m * pitch + lane * 8); }
#pragma unroll
    for (int u = 0; u < 8; ++u) {
        const int m = m0 + u * mstride;
        float y[8] = {bflo(raw[u].x), bfhi(raw[u].x), bflo(raw[u].y), bfhi(raw[u].y), bflo(raw[u].z), bfhi(raw[u].z), bflo(raw[u].w), bfhi(raw[u].w)};
        float ss = 0.f;
#pragma unroll
        for (int e = 0; e < 8; ++e) ss += y[e] * y[e];
        ss = (GLN == 8) ? row8_sum(ss) : row16_sum(ss);
        const float rs = rsqrtf(ss * (1.f / (8 * GLN)) + EPS);
        u32x4 o; o.x = pk2(y[0] * rs * g0.x, y[1] * rs * g0.y); o.y = pk2(y[2] * rs * g0.z, y[3] * rs * g0.w); o.z = pk2(y[4] * rs * g1.x, y[5] * rs * g1.y); o.w = pk2(y[6] * rs * g1.z, y[7] * rs * g1.w);
        if (m < mend) *(u32x4*)(base + (size_t)m * pitch + lane * 8) = o;
    }
}

__device__ __forceinline__ void gdn_prep_pair(const P& p, lptr lds0, int pair, int kn_base, int kn_cnt) {
    int tid_ = threadIdx.x; asm volatile("" : "+v"(tid_));
    const int tid = tid_, lane = tid & 63, wave = __builtin_amdgcn_readfirstlane(tid >> 6), fr = lane & 15, fg = lane >> 4;
    const int st = wave >> 2, ws4 = wave & 3;
    const lptr lds = lds0 + st * PQ_STREAM;
    const int cid = 2 * pair + st;
    const int b = cid >> 7, h = (cid >> 5) & 3, n = cid & 31;
    const int R0 = b * SEQ + n * 64;
    unsigned char* ws = p.ws;
    const float* gates = (const float*)(ws + WS_GATES);
    const bf16* proj = (const bf16*)(ws + WS_PROJ);
    unsigned char* gp = ws + WS_GP + (size_t)cid * GP_CHUNK;
    float gcl = gates[(size_t)(R0 + lane) * 16 + 12 + h];
    const float betal = gates[(size_t)(R0 + lane) * 16 + 8 + h];
#pragma unroll
    for (int o = 1; o < 64; o <<= 1) { const float t = __shfl_up(gcl, o); if (lane >= o) gcl += t; }
    const float glast = rdl(gcl, 63);
    if (ws4 == 0) { ((LAS float*)(lds + PQ_GC))[lane] = gcl; ((LAS float*)(lds + PQ_BETA))[lane] = betal; if (lane == 0) ((float*)(ws + WS_GL))[cid] = __expf(glast); }
    if (lane < 48) {
        const int sec = lane >> 4, oc = lane & 15;
        const int pcol = 1536 + sec * 512 + h * 128 + oc * 8, cc = sec * 512 + h * 128 + oc * 8;
        u32x4 raw[19];
#pragma unroll
        for (int i = 0; i < 19; ++i) {
            const int ts = n * 64 + ws4 * 16 - 3 + i;
            raw[i] = (u32x4){0u, 0u, 0u, 0u};
            if (ts >= 0) raw[i] = *(const u32x4*)(proj + (size_t)(b * SEQ + ts) * NPROJ + pcol);
        }
        float cw[4][8];
#pragma unroll
        for (int j = 0; j < 4; ++j) { const f32x4 a = *(const f32x4*)(p.in[8] + j * 1536 + cc), c2 = *(const f32x4*)(p.in[8] + j * 1536 + cc + 4);
            cw[j][0] = a.x; cw[j][1] = a.y; cw[j][2] = a.z; cw[j][3] = a.w; cw[j][4] = c2.x; cw[j][5] = c2.y; cw[j][6] = c2.z; cw[j][7] = c2.w; }
#pragma unroll
        for (int rr = 0; rr < 16; ++rr) {
            const int r = ws4 * 16 + rr;
            float y[8]; float ss = 0.f;
#pragma unroll
            for (int ch = 0; ch < 8; ++ch) {
                float a = 0.f;
#pragma unroll
                for (int j = 0; j < 4; ++j) { const unsigned wd = raw[rr + j][ch >> 1]; a += cw[j][ch] * ((ch & 1) ? bfhi(wd) : bflo(wd)); }
                a = siluf(a); y[ch] = a; ss += a * a; }
            ss = row16_sum(ss);
            const float rn = rsqrtf(ss + EPS);
            const float gcr = rdl(gcl, r);
            const float s1 = (sec == 0) ? rn * 0.08838834764831845f : ((sec == 1) ? rn : 1.f);
            const float s2 = (sec == 0) ? s1 * __expf(gcr) : s1 * __expf(glast - gcr);
            u32x4 o; o.x = pk2(y[0] * s1, y[1] * s1); o.y = pk2(y[2] * s1, y[3] * s1); o.z = pk2(y[4] * s1, y[5] * s1); o.w = pk2(y[6] * s1, y[7] * s1);
            *(LAS u32x4*)(lds + ((sec == 0) ? PQ_QS : ((sec == 1) ? PQ_KN : PQ_V)) + r * 272 + oc * 16) = o;
            if (sec < 2) {
                u32x4 o2; o2.x = pk2(y[0] * s2, y[1] * s2); o2.y = pk2(y[2] * s2, y[3] * s2); o2.z = pk2(y[4] * s2, y[5] * s2); o2.w = pk2(y[6] * s2, y[7] * s2);
                *(u32x4*)(gp + ((sec == 0) ? GP_QG : GP_KDT) + r * 256 + oc * 16) = o2;
            }
        }
    }
    __syncthreads();
    {
        const LAS float* GC = (const LAS float*)(lds + PQ_GC); const LAS float* BT = (const LAS float*)(lds + PQ_BETA);
        const int ti = ws4;
#pragma unroll
        for (int tj = 0; tj < 4; ++tj) {
            if (tj <= ti) {
                f32x4 c = (f32x4){0.f, 0.f, 0.f, 0.f};
#pragma unroll
                for (int kk = 0; kk < 4; ++kk) c = mfma16(lds8(lds + PQ_KN + (16 * ti + fr) * 272 + (32 * kk + 8 * fg) * 2), lds8(lds + PQ_KN + (16 * tj + fr) * 272 + (32 * kk + 8 * fg) * 2), c);
                const int j = 16 * tj + fr; const float gj = GC[j];
#pragma unroll
                for (int e = 0; e < 4; ++e) { const int i = 16 * ti + 4 * fg + e; const float v = (i > j) ? BT[i] * c[e] * __expf(GC[i] - gj) : 0.f; ((LAS float*)(lds + PQ_LM))[i * 64 + j] = v; }
            }
            {
                const int i = 16 * ti + fr; u32x2 o = (u32x2){0u, 0u};
                if (tj <= ti) {
                    f32x4 c = (f32x4){0.f, 0.f, 0.f, 0.f};
#pragma unroll
                    for (int kk = 0; kk < 4; ++kk) c = mfma16(lds8(lds + PQ_KN + (16 * tj + fr) * 272 + (32 * kk + 8 * fg) * 2), lds8(lds + PQ_QS + (16 * ti + fr) * 272 + (32 * kk + 8 * fg) * 2), c);
                    const float gi = GC[i]; float v[4];
#pragma unroll
                    for (int e = 0; e < 4; ++e) { const int j = 16 * tj + 4 * fg + e; v[e] = (j <= i) ? c[e] * __expf(gi - GC[j]) : 0.f; }
                    o.x = pk2(v[0], v[1]); o.y = pk2(v[2], v[3]);
                }
                *(u32x2*)(gp + GP_IN + i * 128 + (16 * tj + 4 * fg) * 2) = o;
            }
        }
    }
    __syncthreads();
    if (ws4 != st) {
        const int j = (wave <= 4) ? wave - 1 : wave - 2;
        const int m0 = kn_base + 6 * j, mend = (m0 + 6 < kn_base + kn_cnt) ? m0 + 6 : kn_base + kn_cnt;
        if (m0 < mend) knorm_rows8<8>((bf16*)(ws + WS_PROJ) + 512, NPROJ, m0, 1, mend, p.in[5], lane);
        if (j == 5 && kn_cnt > 0) {
            const int hb = (kn_base >> 3);
            f32x4 mr[4][4];
#pragma unroll
            for (int q = 0; q < 4; ++q)
#pragma unroll
                for (int jj = 0; jj < 4; ++jj) mr[q][jj] = ((const f32x4*)(p.in[1] + (size_t)(hb + q) * DM) + lane)[64 * jj];
#pragma unroll
            for (int q = 0; q < 4; ++q) norm_row<false>(p, mr[q], p.in[14], (bf16*)(ws + WS_HM) + (size_t)(hb + q) * DM, nullptr, nullptr, lane);
        }
    }
    if (ws4 == st) {
        typedef float f32x2 __attribute__((ext_vector_type(2)));
        f32x2 tv[32];
#pragma unroll
        for (int q = 0; q < 32; ++q) tv[q] = (f32x2){0.f, 0.f};
        int vz; asm volatile("v_mov_b32 %0, 0" : "=v"(vz));
        const lptr lmb = lds + PQ_LM + vz;
        f32x4 pre[2][8], late[8];
        tv[0].x = (lane == 0) ? 1.f : 0.f;
        pre[1][0] = *(const LAS f32x4*)(lmb + (1 * 64) * 4);
#pragma unroll
        for (int i = 1; i < 64; ++i) {
#pragma unroll
            for (int q = 8; q < (i + 3) / 4; ++q) late[q - 8] = *(const LAS f32x4*)(lmb + (i * 64 + 4 * q) * 4);
            if (i + 1 < 64) {
#pragma unroll
                for (int q = 0; q < (i + 1 + 3) / 4 && q < 8; ++q) pre[(i + 1) & 1][q] = *(const LAS f32x4*)(lmb + ((i + 1) * 64 + 4 * q) * 4);
            }
            __builtin_amdgcn_sched_barrier(0);
            f32x2 A = (f32x2){(i == lane) ? 1.f : 0.f, 0.f}, B = (f32x2){0.f, 0.f};
#pragma unroll
            for (int jb = 0; jb < i; jb += 4) {
                const f32x4 l4 = ((jb >> 2) < 8) ? pre[i & 1][(jb >> 2) & 7] : late[((jb >> 2) - 8) & 7];
                f32x2 lo = (f32x2){l4.x, (jb + 1 < i) ? l4.y : 0.f}, hi = (f32x2){(jb + 2 < i) ? l4.z : 0.f, (jb + 3 < i) ? l4.w : 0.f};
                A -= lo * tv[jb >> 1];
                if (jb + 2 < i) B -= hi * tv[(jb >> 1) + 1];
            }
            const float ti = (A.x + A.y) + (B.x + B.y);
            if (i & 1) tv[i >> 1].y = ti; else tv[i >> 1].x = ti;
            __builtin_amdgcn_sched_barrier(0);
        }
        {
            const float sb = betal, sw = betal * __expf(gcl);
#pragma unroll
            for (int i = 0; i < 64; ++i) { const float tvv = (i & 1) ? tv[i >> 1].y : tv[i >> 1].x;
                *(LAS bf16*)(lds + PQ_TB + i * 144 + lane * 2) = (bf16)(pk2(tvv * sb, 0.f) & 0xffffu);
                *(LAS bf16*)(lds + PQ_TW + i * 144 + lane * 2) = (bf16)(pk2(tvv * sw, 0.f) & 0xffffu); }
        }
    }
    __syncthreads();
#pragma unroll
    for (int q2 = 0; q2 < 2; ++q2) {
        const int tc = 2 * ws4 + q2;
        const int trow = (fr >> 2), tcol = 16 * tc + 4 * (fr & 3);
        bf16x8 bv[2], ak[2];
#pragma unroll
        for (int kk = 0; kk < 2; ++kk) {
            const s16x4 v0 = vtr(lds + PQ_V + (32 * kk + 8 * fg + trow) * 272 + tcol * 2), v1 = vtr(lds + PQ_V + (32 * kk + 8 * fg + 4 + trow) * 272 + tcol * 2);
            const s16x4 k0 = vtr(lds + PQ_KN + (32 * kk + 8 * fg + trow) * 272 + tcol * 2), k1 = vtr(lds + PQ_KN + (32 * kk + 8 * fg + 4 + trow) * 272 + tcol * 2);
            bv[kk] = (bf16x8){v0[0], v0[1], v0[2], v0[3], v1[0], v1[1], v1[2], v1[3]};
            ak[kk] = (bf16x8){k0[0], k0[1], k0[2], k0[3], k1[0], k1[1], k1[2], k1[3]};
        }
#pragma unroll
        for (int ti = 0; ti < 4; ++ti) {
            bf16x8 tb[2], tw[2];
#pragma unroll
            for (int kk = 0; kk < 2; ++kk) { tb[kk] = lds8(lds + PQ_TB + (16 * ti + fr) * 144 + (32 * kk + 8 * fg) * 2); tw[kk] = lds8(lds + PQ_TW + (16 * ti + fr) * 144 + (32 * kk + 8 * fg) * 2); }
            f32x4 cu = (f32x4){0.f, 0.f, 0.f, 0.f}, cw2 = (f32x4){0.f, 0.f, 0.f, 0.f};
#pragma unroll
            for (int kk = 0; kk < 2; ++kk) { cu = mfma16(tb[kk], bv[kk], cu); cw2 = mfma16(ak[kk], tw[kk], cw2); }
            u32x2 ou; ou.x = pk2(cu[0], cu[1]); ou.y = pk2(cu[2], cu[3]);
            *(u32x2*)(gp + GP_UT + (16 * tc + fr) * 128 + (16 * ti + 4 * fg) * 2) = ou;
            u32x2 ow; ow.x = pk2(-cw2[0], -cw2[1]); ow.y = pk2(-cw2[2], -cw2[3]);
            *(u32x2*)(gp + GP_W + (16 * ti + fr) * 256 + (16 * tc + 4 * fg) * 2) = ow;
        }
    }
    __syncthreads();
}

__device__ __forceinline__ void p2_prep(const P& p, lptr lds, int G) {
    const int tid = threadIdx.x, lane = tid & 63, wave = tid >> 6;
    const int gw = blockIdx.x * 8 + wave, NGW = G * 8;
    unsigned char* ws = p.ws;
    const bool kn_fused = (G == 256);
    if (!kn_fused) { for (int m = gw; m < NT; m += 8 * NGW) knorm_rows8<8>((bf16*)(ws + WS_PROJ) + 512, NPROJ, m, NGW, NT, p.in[5], lane); }
    for (int s = ((gw & 15) == 0) ? (gw >> 4) : NB * 8; s < NB * 8; s += (NGW >> 4)) {
        const int b = s >> 3, h = s & 7; const float* gates = (const float*)(ws + WS_GATES) + (size_t)b * SEQ * 16 + h;
        float v[32]; float run = 0.f;
#pragma unroll
        for (int i = 0; i < 32; ++i) { run += gates[(size_t)(lane * 32 + i) * 16]; v[i] = run; }
        float tot = run;
#pragma unroll
        for (int o = 1; o < 64; o <<= 1) { const float t = __shfl_up(tot, o); if (lane >= o) tot += t; }
        const float off = tot - run;
        float* ck = (float*)(ws + WS_CK) + (size_t)s * SEQ + lane * 32;
#pragma unroll
        for (int i = 0; i < 32; ++i) ck[i] = -(v[i] + off) * LOG2E;
    }
    { int it = 0; for (int pair = blockIdx.x; pair < 1024; pair += G, ++it) gdn_prep_pair(p, lds, pair, (int)blockIdx.x * 128 + 32 * it, kn_fused ? 32 : 0); }
}
constexpr int SC_WL = 0, SC_QGL = 17408, SC_KDL = 34816, SC_UTL = 53248, SC_INL = 71680, SC_ST = 80896, SC_VNT = 115712, SC_SSQ = 134144, SC_RSTD = 136192;

__device__ __forceinline__ void gdn_scan_task(const P& p, lptr lds, int tsk) {
    int tid_ = threadIdx.x; asm volatile("" : "+v"(tid_));
    const int tid = tid_, lane = tid & 63, wave = __builtin_amdgcn_readfirstlane(tid >> 6), fr = lane & 15, fg = lane >> 4;
    const int b = tsk >> 2, h = tsk & 3;
    unsigned char* ws = p.ws;
    const unsigned char* gp0 = ws + WS_GP + (size_t)tsk * 32 * GP_CHUNK;
    const float* GL = (const float*)(ws + WS_GL) + tsk * 32;
    const bf16* zbase = (const bf16*)(ws + WS_PROJ) + (size_t)b * SEQ * NPROJ + 3072 + h * 128;
    bf16* mbase = (bf16*)(ws + WS_BUFA) + (size_t)b * SEQ * DM + 512 + h * 128;
    const int ecol = 16 * wave + fr;
    const float og = p.in[11][ecol];
    u32x4 pf[9];
    auto issue = [&](int n) {
        const unsigned char* g = gp0 + (size_t)n * GP_CHUNK;
#pragma unroll
        for (int k = 0; k < 2; ++k) { pf[k] = *(const u32x4*)(g + GP_W + (tid + 512 * k) * 16); pf[2 + k] = *(const u32x4*)(g + GP_QG + (tid + 512 * k) * 16);
            pf[4 + k] = *(const u32x4*)(g + GP_KDT + (tid + 512 * k) * 16); pf[6 + k] = *(const u32x4*)(g + GP_UT + (tid + 512 * k) * 16); }
        pf[8] = *(const u32x4*)(g + GP_IN + tid * 16);
    };
    auto commit = [&]() {
#pragma unroll
        for (int k = 0; k < 2; ++k) { const int q = tid + 512 * k;
            *(LAS u32x4*)(lds + SC_WL + (q >> 4) * 272 + (q & 15) * 16) = pf[k]; *(LAS u32x4*)(lds + SC_QGL + (q >> 4) * 272 + (q & 15) * 16) = pf[2 + k];
            *(LAS u32x4*)(lds + SC_KDL + (q >> 4) * 272 + (q & 15) * 16) = pf[4 + k]; *(LAS u32x4*)(lds + SC_UTL + (q >> 3) * 144 + (q & 7) * 16) = pf[6 + k]; }
        *(LAS u32x4*)(lds + SC_INL + (tid >> 3) * 144 + (tid & 7) * 16) = pf[8];
    };
    f32x4 sacc[8];
#pragma unroll
    for (int td = 0; td < 8; ++td) sacc[td] = (f32x4){0.f, 0.f, 0.f, 0.f};
    for (int q = lane; q < 272; q += 64) *(LAS u32x4*)(lds + SC_ST + (16 * wave) * 272 + q * 16) = (u32x4){0u, 0u, 0u, 0u};
    issue(0); commit();
    __syncthreads();
    for (int n = 0; n < 32; ++n) {
#ifndef X_NOLOAD
        if (n + 1 < 32) issue(n + 1);
#endif
        const float eg = GL[n];
        const unsigned zoff0 = (unsigned)((n * 64 + 4 * fg) * NPROJ + ecol), moff0 = (unsigned)((n * 64 + 4 * fg) * DM + ecol);
        unsigned short zr[16];
#pragma unroll
        for (int ti = 0; ti < 4; ++ti)
#pragma unroll
            for (int e = 0; e < 4; ++e) {
#ifndef X_NOEPI
                zr[ti * 4 + e] = zbase[zoff0 + (unsigned)((16 * ti + e) * NPROJ)];
#else
                zr[ti * 4 + e] = 0x3f80;
#endif
            }
        bf16x8 bs[4];
        f32x4 acc[4];
#pragma unroll
        for (int kk = 0; kk < 4; ++kk) bs[kk] = lds8(lds + SC_ST + ecol * 272 + (32 * kk + 8 * fg) * 2);
#pragma unroll
        for (int th = 0; th < 2; ++th) {
            bf16x8 wa[2][4]; u32x2 uu[2];
#pragma unroll
            for (int t2 = 0; t2 < 2; ++t2) { const int ti = 2 * th + t2;
                uu[t2] = *(const LAS u32x2*)(lds + SC_UTL + ecol * 144 + (16 * ti + 4 * fg) * 2);
#pragma unroll
                for (int kk = 0; kk < 4; ++kk) wa[t2][kk] = lds8(lds + SC_WL + (16 * ti + fr) * 272 + (32 * kk + 8 * fg) * 2);
            }
            __builtin_amdgcn_sched_barrier(0);
#pragma unroll
            for (int t2 = 0; t2 < 2; ++t2) acc[2 * th + t2] = (f32x4){bflo(uu[t2].x), bfhi(uu[t2].x), bflo(uu[t2].y), bfhi(uu[t2].y)};
            __builtin_amdgcn_s_setprio(1);
#pragma unroll
            for (int kk = 0; kk < 4; ++kk)
#pragma unroll
                for (int t2 = 0; t2 < 2; ++t2) acc[2 * th + t2] = mfma16(wa[t2][kk], bs[kk], acc[2 * th + t2]);
            __builtin_amdgcn_s_setprio(0);
#pragma unroll
            for (int t2 = 0; t2 < 2; ++t2) { const int ti = 2 * th + t2;
                u32x2 o; o.x = pk2(acc[ti][0], acc[ti][1]); o.y = pk2(acc[ti][2], acc[ti][3]);
                *(LAS u32x2*)(lds + SC_VNT + ecol * 144 + (16 * ti + 4 * fg) * 2) = o;
            }
            __builtin_amdgcn_sched_barrier(0);
        }
        LDS_WAIT();
        bf16x8 vn[2];
        f32x4 oacc[4];
#pragma unroll
        for (int kk = 0; kk < 2; ++kk) vn[kk] = lds8(lds + SC_VNT + ecol * 144 + (32 * kk + 8 * fg) * 2);
#pragma unroll
        for (int th = 0; th < 2; ++th) {
            bf16x8 qa[2][4], ia[2][2];
#pragma unroll
            for (int t2 = 0; t2 < 2; ++t2) { const int ti = 2 * th + t2;
#pragma unroll
                for (int kk = 0; kk < 4; ++kk) qa[t2][kk] = lds8(lds + SC_QGL + (16 * ti + fr) * 272 + (32 * kk + 8 * fg) * 2);
#pragma unroll
                for (int kk = 0; kk < 2; ++kk) ia[t2][kk] = lds8(lds + SC_INL + (16 * ti + fr) * 144 + (32 * kk + 8 * fg) * 2);
            }
            __builtin_amdgcn_sched_barrier(0);
#pragma unroll
            for (int t2 = 0; t2 < 2; ++t2) oacc[2 * th + t2] = (f32x4){0.f, 0.f, 0.f, 0.f};
            __builtin_amdgcn_s_setprio(1);
#pragma unroll
            for (int kk = 0; kk < 4; ++kk)
#pragma unroll
                for (int t2 = 0; t2 < 2; ++t2) oacc[2 * th + t2] = mfma16(qa[t2][kk], bs[kk], oacc[2 * th + t2]);
#pragma unroll
            for (int kk = 0; kk < 2; ++kk)
#pragma unroll
                for (int t2 = 0; t2 < 2; ++t2) oacc[2 * th + t2] = mfma16(ia[t2][kk], vn[kk], oacc[2 * th + t2]);
            __builtin_amdgcn_s_setprio(0);
            __builtin_amdgcn_sched_barrier(0);
        }
#pragma unroll
        for (int th = 0; th < 2; ++th) {
            bf16x8 ka[4][2];
#pragma unroll
            for (int t4 = 0; t4 < 4; ++t4)
#pragma unroll
                for (int kk = 0; kk < 2; ++kk) {
                    const lptr ap = lds + SC_KDL + (32 * kk + 8 * fg + (fr >> 2)) * 272 + (16 * (4 * th + t4) + 4 * (fr & 3)) * 2;
                    const s16x4 a0 = vtr(ap), a1 = vtr(ap + 4 * 272);
                    ka[t4][kk] = (bf16x8){a0[0], a0[1], a0[2], a0[3], a1[0], a1[1], a1[2], a1[3]};
                }
            __builtin_amdgcn_sched_barrier(0);
#pragma unroll
            for (int t4 = 0; t4 < 4; ++t4) sacc[4 * th + t4] = sacc[4 * th + t4] * eg;
            __builtin_amdgcn_s_setprio(1);
#pragma unroll
            for (int kk = 0; kk < 2; ++kk)
#pragma unroll
                for (int t4 = 0; t4 < 4; ++t4) sacc[4 * th + t4] = mfma16(ka[t4][kk], vn[kk], sacc[4 * th + t4]);
            __builtin_amdgcn_s_setprio(0);
#pragma unroll
            for (int t4 = 0; t4 < 4; ++t4) { const int td = 4 * th + t4;
                u32x2 o; o.x = pk2(sacc[td][0], sacc[td][1]); o.y = pk2(sacc[td][2], sacc[td][3]);
                *(LAS u32x2*)(lds + SC_ST + ecol * 272 + (16 * td + 4 * fg) * 2) = o;
            }
            __builtin_amdgcn_sched_barrier(0);
        }
        {
            f32x4 sq[4];
#pragma unroll
            for (int ti = 0; ti < 4; ++ti)
#pragma unroll
                for (int e = 0; e < 4; ++e) sq[ti][e] = row16_sum(oacc[ti][e] * oacc[ti][e]);
            if (fr == 0) {
#pragma unroll
                for (int ti = 0; ti < 4; ++ti) *(LAS f32x4*)(lds + SC_SSQ + (wave * 64 + 16 * ti + 4 * fg) * 4) = sq[ti];
            }
        }
        LDS_WAIT(); __builtin_amdgcn_s_barrier(); asm volatile("" ::: "memory");
#ifndef X_NOLOAD
        if (n + 1 < 32) commit();
#endif
        if (tid < 64) { float s = 0.f;
#pragma unroll
            for (int w = 0; w < 8; ++w) s += ((const LAS float*)(lds + SC_SSQ))[w * 64 + tid];
            ((LAS float*)(lds + SC_RSTD))[tid] = rsqrtf(s * (1.f / 128.f) + EPS); }
        LDS_WAIT(); __builtin_amdgcn_s_barrier(); asm volatile("" ::: "memory");
#pragma unroll
        for (int ti = 0; ti < 4; ++ti) {
            const f32x4 rs = *(const LAS f32x4*)(lds + SC_RSTD + (16 * ti + 4 * fg) * 4);
#pragma unroll
            for (int e = 0; e < 4; ++e) {
                const float z = __uint_as_float((unsigned)zr[ti * 4 + e] << 16);
                const float v = oacc[ti][e] * rs[e] * og * siluf(z);
#ifndef X_NOEPI
                mbase[moff0 + (unsigned)((16 * ti + e) * DM)] = (bf16)(pk2(v, 0.f) & 0xffffu);
#else
                if (v == 123.456f) mix[0] = 0;
#endif
            }
        }
    }
    __syncthreads();
}

constexpr int AT_ALPHA = 70144, AT_OST = 73728;
__device__ __forceinline__ int crow(int r, int hi) { return (r & 3) + 8 * (r >> 2) + 4 * hi; }

template <int D, bool FOX>
__device__ __forceinline__ void attn_unit(lptr lds, const bf16* Qp, int qpitch, const bf16* Kp, const bf16* Vp, int kvpitch, int ntiles, int q0,
                                          const float* qgain, float qscale, const float* bias, bf16* Op, int opitch, const float* ogain) {
    constexpr int PITCH = D * 2 + 16, TILEB = 64 * PITCH, ND = D / 16, NDB = D / 32, NCH = D / 64;
    constexpr int OFF_K = 0, OFF_V = 2 * TILEB, OFF_B = 4 * TILEB;
    int tid_ = threadIdx.x; asm volatile("" : "+v"(tid_));
    const int tid = tid_, lane = tid & 63, wave = __builtin_amdgcn_readfirstlane(tid >> 6), r32 = lane & 31, hi = lane >> 5;
    bf16x8 qf[ND];
    {
        const bf16* qrow = Qp + (size_t)(32 * wave + r32) * qpitch;
        float qv[ND][8]; float ss = 0.f;
#pragma unroll
        for (int d0 = 0; d0 < ND; ++d0) { const u32x4 raw = *(const u32x4*)(qrow + 16 * d0 + 8 * hi);
            qv[d0][0] = bflo(raw.x); qv[d0][1] = bfhi(raw.x); qv[d0][2] = bflo(raw.y); qv[d0][3] = bfhi(raw.y); qv[d0][4] = bflo(raw.z); qv[d0][5] = bfhi(raw.z); qv[d0][6] = bflo(raw.w); qv[d0][7] = bfhi(raw.w);
#pragma unroll
            for (int e = 0; e < 8; ++e) ss += qv[d0][e] * qv[d0][e]; }
        ss += xor32(ss);
        const float rs = rsqrtf(ss * (1.f / D) + EPS) * qscale;
#pragma unroll
        for (int d0 = 0; d0 < ND; ++d0) { const f32x4 g0 = *(const f32x4*)(qgain + 16 * d0 + 8 * hi), g1 = *(const f32x4*)(qgain + 16 * d0 + 8 * hi + 4);
            u32x4 o; o.x = pk2(qv[d0][0] * rs * g0.x, qv[d0][1] * rs * g0.y); o.y = pk2(qv[d0][2] * rs * g0.z, qv[d0][3] * rs * g0.w);
            o.z = pk2(qv[d0][4] * rs * g1.x, qv[d0][5] * rs * g1.y); o.w = pk2(qv[d0][6] * rs * g1.z, qv[d0][7] * rs * g1.w);
            qf[d0] = __builtin_bit_cast(bf16x8, o); }
    }
    f32x16 o[NDB];
#pragma unroll
    for (int db = 0; db < NDB; ++db) o[db] = f32x16{};
    float lrun = 0.f;
    const int wave_last = FOX ? ((q0 + 32 * wave + 31) >> 6) : (ntiles - 1);
    const int qpos = q0 + 32 * wave + r32;
    const float mref = (FOX ? bias[qpos] : 0.f) + 8.f;
    constexpr int DEPTH = (D == 64) ? 3 : 1;
    u32x4 kr[DEPTH][NCH], vr[DEPTH][NCH]; float br[DEPTH];
#define AT_ISSUE(slot, kt_) do { _Pragma("unroll") for (int c = 0; c < NCH; ++c) { const int q = tid + 512 * c, row = q / (D / 8), cc = q % (D / 8); \
            kr[slot][c] = *(const u32x4*)(Kp + (size_t)((kt_) * 64 + row) * kvpitch + cc * 8); vr[slot][c] = *(const u32x4*)(Vp + (size_t)((kt_) * 64 + row) * kvpitch + cc * 8); } \
        br[slot] = 0.f; if (FOX && tid < 64) br[slot] = bias[(kt_) * 64 + tid]; } while (0)
#define AT_COMMIT(slot, buf_) do { _Pragma("unroll") for (int c = 0; c < NCH; ++c) { const int q = tid + 512 * c, row = q / (D / 8), cc = q % (D / 8); \
            *(LAS u32x4*)(lds + OFF_K + (buf_) * TILEB + row * PITCH + cc * 16) = kr[slot][c]; *(LAS u32x4*)(lds + OFF_V + (buf_) * TILEB + row * PITCH + cc * 16) = vr[slot][c]; } \
        if (FOX && tid < 64) ((LAS float*)(lds + OFF_B + (buf_) * 256))[tid] = br[slot]; } while (0)
    LAS float* alpha = (LAS float*)(lds + AT_ALPHA + wave * 128);
    AT_ISSUE(0, 0); AT_COMMIT(0, 0);
#pragma unroll
    for (int d = 1; d < DEPTH; ++d) { if (d < ntiles) AT_ISSUE(d, d); }
    __syncthreads();
    for (int kt0 = 0; kt0 < ntiles; kt0 += DEPTH) {
#pragma unroll
      for (int jj = 0; jj < DEPTH; ++jj) {
        const int kt = kt0 + jj;
        if (kt < ntiles) {
        const int buf = kt & 1;
        if (kt + DEPTH < ntiles) AT_ISSUE(jj, kt + DEPTH);
        if (kt <= wave_last) {
            f32x16 p0, p1;
            if (FOX) {
#pragma unroll
                for (int a = 0; a < 4; ++a) { const f32x4 b0 = *(const LAS f32x4*)(lds + OFF_B + buf * 256 + (8 * a + 4 * hi) * 4), b1 = *(const LAS f32x4*)(lds + OFF_B + buf * 256 + (32 + 8 * a + 4 * hi) * 4);
#pragma unroll
                    for (int e = 0; e < 4; ++e) { p0[4 * a + e] = b0[e]; p1[4 * a + e] = b1[e]; } }
            } else {
#pragma unroll
                for (int r = 0; r < 16; ++r) { p0[r] = -mref; p1[r] = -mref; } }
            const lptr kb = lds + OFF_K + buf * TILEB + r32 * PITCH + hi * 16;
#pragma unroll
            for (int dh = 0; dh < ND / 4; ++dh) {
                bf16x8 kf0[4], kf1[4];
#pragma unroll
                for (int d0 = 0; d0 < 4; ++d0) { kf0[d0] = lds8(kb + (4 * dh + d0) * 32); kf1[d0] = lds8(kb + 32 * PITCH + (4 * dh + d0) * 32); }
                __builtin_amdgcn_sched_barrier(0);
                __builtin_amdgcn_s_setprio(1);
#pragma unroll
                for (int d0 = 0; d0 < 4; ++d0) { p0 = mfma32(kf0[d0], qf[4 * dh + d0], p0); p1 = mfma32(kf1[d0], qf[4 * dh + d0], p1); }
                __builtin_amdgcn_s_setprio(0);
                __builtin_amdgcn_sched_barrier(0);
            }
            const lptr vb = lds + OFF_V + buf * TILEB + (4 * hi + ((lane & 15) >> 2)) * PITCH + (((lane >> 4) & 1) * 16 + (lane & 3) * 4) * 2;
            s16x4 vlo[2][4], vhh[2][4];
#pragma unroll
            for (int db = 0; db < 2; ++db)
#pragma unroll
                for (int s = 0; s < 4; ++s) { vlo[db][s] = vtr(vb + (16 * s) * PITCH + db * 64); vhh[db][s] = vtr(vb + (16 * s + 8) * PITCH + db * 64); }
            __builtin_amdgcn_sched_barrier(0);
            if (FOX && (kt * 64 + 63 > q0 + 32 * wave)) {
#pragma unroll
                for (int r = 0; r < 16; ++r) { const int key = kt * 64 + crow(r, hi); if (key > qpos) p0[r] = -INFINITY; if (key + 32 > qpos) p1[r] = -INFINITY; }
            }
            if (FOX) { p0 = p0 - mref; p1 = p1 - mref; }
#pragma unroll
            for (int r = 0; r < 16; ++r) { p0[r] = __builtin_amdgcn_exp2f(p0[r]); p1[r] = __builtin_amdgcn_exp2f(p1[r]); }
            {
                const f32x16 ps = p0 + p1;
                const float ls = ((ps[0] + ps[1]) + (ps[2] + ps[3])) + ((ps[4] + ps[5]) + (ps[6] + ps[7])) + (((ps[8] + ps[9]) + (ps[10] + ps[11])) + ((ps[12] + ps[13]) + (ps[14] + ps[15])));
                lrun += ls;
            }
            bf16x8 pa[4];
            { u32x4 w;
              w.x = pk2(p0[0], p0[1]); w.y = pk2(p0[2], p0[3]); w.z = pk2(p0[4], p0[5]); w.w = pk2(p0[6], p0[7]); pa[0] = __builtin_bit_cast(bf16x8, w);
              w.x = pk2(p0[8], p0[9]); w.y = pk2(p0[10], p0[11]); w.z = pk2(p0[12], p0[13]); w.w = pk2(p0[14], p0[15]); pa[1] = __builtin_bit_cast(bf16x8, w);
              w.x = pk2(p1[0], p1[1]); w.y = pk2(p1[2], p1[3]); w.z = pk2(p1[4], p1[5]); w.w = pk2(p1[6], p1[7]); pa[2] = __builtin_bit_cast(bf16x8, w);
              w.x = pk2(p1[8], p1[9]); w.y = pk2(p1[10], p1[11]); w.z = pk2(p1[12], p1[13]); w.w = pk2(p1[14], p1[15]); pa[3] = __builtin_bit_cast(bf16x8, w); }
#pragma unroll
            for (int dp = 0; dp < NDB / 2; ++dp) {
                if (dp > 0) {
#pragma unroll
                    for (int db = 0; db < 2; ++db)
#pragma unroll
                        for (int s = 0; s < 4; ++s) { vlo[db][s] = vtr(vb + (16 * s) * PITCH + (2 * dp + db) * 64); vhh[db][s] = vtr(vb + (16 * s + 8) * PITCH + (2 * dp + db) * 64); }
                    __builtin_amdgcn_sched_barrier(0);
                }
                __builtin_amdgcn_s_setprio(1);
#pragma unroll
                for (int db = 0; db < 2; ++db)
#pragma unroll
                    for (int s = 0; s < 4; ++s) {
                        const bf16x8 vf = (bf16x8){vlo[db][s][0], vlo[db][s][1], vlo[db][s][2], vlo[db][s][3], vhh[db][s][0], vhh[db][s][1], vhh[db][s][2], vhh[db][s][3]};
                        o[2 * dp + db] = mfma32(pa[s], vf, o[2 * dp + db]);
                    }
                __builtin_amdgcn_s_setprio(0);
            }
        }
        if (kt + 1 < ntiles) AT_COMMIT((jj + 1) % DEPTH, buf ^ 1);
        __syncthreads();
        }
      }
    }
#undef AT_ISSUE
#undef AT_COMMIT
    lrun += xor32(lrun);
    if (hi == 0) alpha[r32] = 1.f / lrun;
    LDS_WAIT();
    f32x4 inv[4];
#pragma unroll
    for (int a = 0; a < 4; ++a) inv[a] = *(const LAS f32x4*)((lptr)alpha + (8 * a + 4 * hi) * 4);
    LAS float* ost = (LAS float*)(lds + AT_OST + wave * 8704);
#pragma unroll
    for (int ps = 0; ps < NDB / 2; ++ps) {
#pragma unroll
        for (int dbl = 0; dbl < 2; ++dbl)
#pragma unroll
            for (int r = 0; r < 16; ++r) ost[crow(r, hi) * 68 + dbl * 32 + r32] = o[ps * 2 + dbl][r] * inv[r >> 2][r & 3];
        LDS_WAIT();
        const int q = lane >> 1, half = lane & 1;
        float v[32]; float ss = 0.f;
#pragma unroll
        for (int c = 0; c < 8; ++c) { const f32x4 t = *(const LAS f32x4*)((lptr)ost + (q * 68 + half * 32 + 4 * c) * 4); v[4 * c] = t.x; v[4 * c + 1] = t.y; v[4 * c + 2] = t.z; v[4 * c + 3] = t.w; }
        float rs = 1.f;
        if (FOX) {
#pragma unroll
            for (int e = 0; e < 32; ++e) ss += v[e] * v[e];
            ss = dpp_add<0xB1>(ss);
            rs = rsqrtf(ss * (1.f / 64.f) + EPS);
        }
        bf16* op = Op + (size_t)(32 * wave + q) * opitch + ps * 64 + half * 32;
#pragma unroll
        for (int c = 0; c < 4; ++c) {
            float g[8];
#pragma unroll
            for (int e = 0; e < 8; ++e) g[e] = FOX ? ogain[half * 32 + 8 * c + e] * rs : 1.f;
            u32x4 w; w.x = pk2(v[8 * c] * g[0], v[8 * c + 1] * g[1]); w.y = pk2(v[8 * c + 2] * g[2], v[8 * c + 3] * g[3]); w.z = pk2(v[8 * c + 4] * g[4], v[8 * c + 5] * g[5]); w.w = pk2(v[8 * c + 6] * g[6], v[8 * c + 7] * g[7]);
            *(u32x4*)(op + 8 * c) = w;
        }
        LDS_WAIT();
    }
    __syncthreads();
}
#define XB_TMO      128
#define XB_XCNT(j)  (256  + 64 * (j))
#define XB_XSUB(j)  (1280 + 64 * (j))
#define XB_XGEN(j)  (2304 + 64 * (j))
#define XB_TOP      3328
#define XB_TOPGEN   3392
#define XCD_BAR_WORDS 3456
#define XB_SPIN_CAP (1u << 18)

__device__ __forceinline__ unsigned xb_ld(unsigned* p)              { return __hip_atomic_load(p, __ATOMIC_RELAXED, __HIP_MEMORY_SCOPE_AGENT); }
__device__ __forceinline__ unsigned xb_add(unsigned* p, unsigned v) { return __hip_atomic_fetch_add(p, v, __ATOMIC_RELAXED, __HIP_MEMORY_SCOPE_AGENT); }
__device__ __forceinline__ unsigned xb_xcc_id() { return (unsigned)__builtin_amdgcn_s_getreg((3 << 11) | 20) & 0xFu; }
#define XB_SPIN(cond, bar) do { unsigned _sp = 0; while (cond) { __builtin_amdgcn_s_sleep(1); \
    if ((++_sp & 255u) == 0u) { if (xb_ld(&(bar)[XB_TMO])) break; if (_sp > XB_SPIN_CAP) { atomicAdd(&(bar)[XB_TMO], 1u); break; } } } } while (0)

struct XcdBarrier {
    unsigned* bar; unsigned x;
    volatile LAS unsigned* st;
};

__device__ __forceinline__ XcdBarrier xcd_barrier_post(unsigned* bar, volatile LAS unsigned* st) {
    XcdBarrier b; b.bar = bar; b.x = xb_xcc_id(); b.st = st;
    if (threadIdx.x == 0) (void)xb_add(&bar[XB_XCNT(b.x)], 1u);
    return b;
}
__device__ __forceinline__ void xcd_barrier_complete(unsigned* bar, unsigned x, unsigned& nloc, unsigned& nx) {
    const unsigned G = gridDim.x * gridDim.y * gridDim.z;
    unsigned sum, cnt, mine, sp = 0u;
    for (;;) {
        sum = 0u; cnt = 0u; mine = 0u;
#pragma unroll
        for (unsigned j = 0; j < 16; ++j) { const unsigned c = xb_ld(&bar[XB_XCNT(j)]); sum += c; cnt += (c > 0u) ? 1u : 0u; mine = (j == x) ? c : mine; }
        if (sum == G) break;
        __builtin_amdgcn_s_sleep(1);
        if ((++sp & 255u) == 0u) { if (xb_ld(&bar[XB_TMO])) break; if (sp > XB_SPIN_CAP) { atomicAdd(&bar[XB_TMO], 1u); break; } }
    }
    nloc = mine > 0u ? mine : 1u; nx = cnt > 0u ? cnt : 1u;
}

__device__ __forceinline__ void xcd_barrier(const XcdBarrier& b) {
    asm volatile("s_waitcnt vmcnt(0)" ::: "memory");
    __syncthreads();
    if (threadIdx.x == 0) {
        unsigned* bar = b.bar;
        __builtin_amdgcn_s_waitcnt(0);
        unsigned nloc = b.st[0], nx = b.st[1];
        if (nloc == 0u) { xcd_barrier_complete(bar, b.x, nloc, nx); b.st[0] = nloc; b.st[1] = nx; }
        const unsigned old = xb_add(&bar[XB_XSUB(b.x)], 1u);
        const unsigned gen = old / nloc;
        if (old + 1u == (gen + 1u) * nloc) {
            __builtin_amdgcn_fence(__ATOMIC_RELEASE, "agent");
            asm volatile("s_waitcnt vmcnt(0)" ::: "memory");
            const unsigned og = xb_add(&bar[XB_TOP], 1u);
            const unsigned tg = og / nx;
            if (og + 1u == (tg + 1u) * nx) xb_add(&bar[XB_TOPGEN], 1u);
            else XB_SPIN(xb_ld(&bar[XB_TOPGEN]) == tg, bar);
            __builtin_amdgcn_fence(__ATOMIC_ACQUIRE, "agent");
            xb_add(&bar[XB_XGEN(b.x)], 1u);
            asm volatile("s_waitcnt vmcnt(0)" ::: "memory");
        } else {
            XB_SPIN(xb_ld(&bar[XB_XGEN(b.x)]) == gen, bar);
            __builtin_amdgcn_fence(__ATOMIC_ACQUIRE, "agent");
            asm volatile("s_waitcnt vmcnt(0)" ::: "memory");
        }
    }
    __syncthreads();
}

struct Args { P p; int ph_lo, ph_hi; };

__global__ void __launch_bounds__(512, 2) fwd(Args a) {
    extern __shared__ __attribute__((aligned(16))) unsigned char lds_raw[];
    const lptr lds = (lptr)lds_raw;
    const P& p = a.p;
    const int G = gridDim.x, tid = threadIdx.x;
    unsigned char* ws = p.ws;
    cg::grid_group grid = cg::this_grid();
    const int lo = a.ph_lo, hi = a.ph_hi;
    volatile LAS unsigned* xst = (volatile LAS unsigned*)(lds + LDS_MISC + 16);
    if (tid == 0) { xst[0] = 0u; xst[1] = 0u; }
    __syncthreads();
    XcdBarrier xbar = xcd_barrier_post((unsigned*)(ws + WS_BARW), xst);
#ifndef PH_MASK
#define PH_MASK 0x3ff
#endif
#define IN(k) (((PH_MASK >> (k)) & 1) && lo <= (k) && (k) < hi)
#ifdef PROBE_PH
#define STAMP(k) do { if (blockIdx.x == 0 && tid == 0) ((unsigned long long*)(ws + WS_CTL + 1024))[k] = __builtin_amdgcn_s_memrealtime(); } while (0)
#else
#define STAMP(k) do { } while (0)
#endif
#define SEAM(k) do { if (IN((k) + 1)) xcd_barrier(xbar); STAMP((k) + 1); } while (0)
    if (a.ph_hi > NPH + 100) grid.sync();
    STAMP(0);
    typedef pg8::bf16_t pb;
    if (IN(0)) { p0_prologue(p, lds, G); SEAM(0); }
    if (IN(1)) {
        { pg8::Gemm g{(const pb*)(ws + WS_BUFA), (const pb*)(ws + WS_WIN), NT, NPROJ, DM}; pg8::StaticOrder S; S.init(NT, NPROJ, G, (int)blockIdx.x);
          pg8::EpiStore<0, false> E{(pb*)(ws + WS_PROJ), NPROJ, nullptr};
          pg8::gemm_phase<pg8::EpiStore<0, false>, pg8::StaticOrder, true, true>(lds, g, S, E); }
        SEAM(1);
    }
    if (IN(2)) { p2_prep(p, lds, G); SEAM(2); }
    if (IN(3)) {
        unsigned* ctr = (unsigned*)(ws + WS_CTL);
        volatile LAS unsigned* slot = (volatile LAS unsigned*)(lds + LDS_MISC);
        for (;;) {
            __syncthreads();
            if (tid == 0) *slot = atomicAdd(ctr, 1u);
            __syncthreads();
            const unsigned tk = *slot;
            const unsigned id = (tk >= 576u && tk < 640u) ? (1088u + (tk - 576u)) : ((tk >= 640u && tk < 1152u) ? (tk - 64u) : tk);
            if (id >= 64u + 1024u + 64u + (unsigned)(LATE_ITEMS / 8)) break;
            if (id >= 64u + 1024u + 64u) {
                const int t = (int)(id - (64u + 1024u + 64u));
                int tl = threadIdx.x; asm volatile("" : "+v"(tl));
                late_transpose_item(p, (LAS float*)(lds + 65536 + (tl >> 6) * 8448), 8 * t + __builtin_amdgcn_readfirstlane(tl >> 6), tl & 63);
            }
            else if (id >= 64u + 1024u) {
                const unsigned gu = id - (64u + 1024u);
                pg8::Gemm g{(const pb*)(ws + WS_HM), (const pb*)(ws + WS_WCKV), MEMR, 1024, DM};
                pg8::OneUnit S{(int)(gu >> 2), (int)(gu & 3)};
                pg8::EpiStore<0, false> E{(pb*)(ws + WS_CKV), 1024, nullptr};
                pg8::gemm_phase<pg8::EpiStore<0, false>, pg8::OneUnit, true, true>(lds, g, S, E);
            }
            else if (id < 64u) {
#ifndef NO_SCAN
                gdn_scan_task(p, lds, (int)id);
#endif
            }
#ifndef NO_ATTN
            else {
                const int idx = (int)id - 64, qb = 7 - (idx >> 7), bh = idx & 127, b = bh >> 3, h = bh & 7;
                const bf16* proj = (const bf16*)(ws + WS_PROJ);
                const size_t r0 = (size_t)b * SEQ;
                attn_unit<64, true>(lds, proj + (r0 + 256 * qb) * NPROJ + h * 64, NPROJ, proj + r0 * NPROJ + 512 + h * 64, proj + r0 * NPROJ + 1024 + h * 64, NPROJ,
                                    4 * qb + 4, 256 * qb, p.in[4], 0.125f * LOG2E, (const float*)(ws + WS_CK) + (size_t)bh * SEQ,
                                    (bf16*)(ws + WS_BUFA) + (r0 + 256 * qb) * DM + h * 64, DM, p.in[7]);
            }
#endif
        }
        SEAM(3);
    }
    if (IN(4)) {
        { const int lane = tid & 63, gw = blockIdx.x * 8 + (tid >> 6), NGW = G * 8;
          for (int m = gw; m < MEMR; m += 8 * NGW) knorm_rows8<16>((bf16*)(ws + WS_CKV), 1024, m, NGW, MEMR, p.in[18], lane); }
        pg8::Gemm g{(const pb*)(ws + WS_BUFA), (const pb*)(ws + WS_WOUT), NT, DM, DM}; pg8::StaticOrder S; S.init(NT, DM, G, (int)blockIdx.x);
        pg8::EpiRes<false, false> E{p.in[0], nullptr, (pb*)(ws + WS_XB1), (float*)(ws + WS_SSQ1)};
        pg8::gemm_phase<pg8::EpiRes<false, false>, pg8::StaticOrder, true, true>(lds, g, S, E);
        SEAM(4);
    }
    if (IN(5)) {
        pg8::Gemm g{(const pb*)(ws + WS_XB1), (const pb*)(ws + WS_WCQ), NT, 512, DM}; pg8::StaticOrder S; S.init(NT, 512, G, (int)blockIdx.x);
        pg8::EpiStore<0, true> E{(pb*)(ws + WS_CQ), 512, (const float*)(ws + WS_SSQ1)};
        pg8::gemm_phase<pg8::EpiStore<0, true>, pg8::StaticOrder, true, true>(lds, g, S, E);
        SEAM(5);
    }
    if (IN(6)) {
        for (int ui = 2 * (int)blockIdx.x; ui < 512; ui += 2 * G)
        for (int u = ui; u < ui + 2 && u < 512; ++u) {
            const int qb = u & 7, bh = u >> 3, b = bh >> 2, h = bh & 3;
            const bf16* cq = (const bf16*)(ws + WS_CQ); const bf16* ckv = (const bf16*)(ws + WS_CKV);
            const size_t r0 = (size_t)b * SEQ + 256 * qb;
            attn_unit<128, false>(lds, cq + r0 * 512 + h * 128, 512, ckv + (size_t)b * 256 * 1024 + h * 128, ckv + (size_t)b * 256 * 1024 + 512 + h * 128, 1024,
                                  4, 0, p.in[17], 0.08838834764831845f * LOG2E, nullptr, (bf16*)(ws + WS_CO) + r0 * 512 + h * 128, 512, nullptr);
        }
        SEAM(6);
    }
    if (IN(7)) {
        pg8::Gemm g{(const pb*)(ws + WS_CO), (const pb*)(ws + WS_WCO), NT, DM, 512}; pg8::StaticOrder S; S.init(NT, DM, G, (int)blockIdx.x);
        pg8::EpiRes<true, false> E{(const void*)(ws + WS_XB1), nullptr, (pb*)(ws + WS_BUFA), (float*)(ws + WS_SSQ2)};
        pg8::gemm_phase<pg8::EpiRes<true, false>, pg8::StaticOrder, true, true>(lds, g, S, E);
        SEAM(7);
    }
    if (IN(8)) {
        pg8::Gemm g{(const pb*)(ws + WS_BUFA), (const pb*)(ws + WS_W1), NT, DFF, DM}; pg8::StaticOrder S; S.init(NT, DFF, G, (int)blockIdx.x);
        pg8::EpiStore<2, true> E{(pb*)(ws + WS_HMID), DFF, (const float*)(ws + WS_SSQ2)};
        pg8::gemm_phase<pg8::EpiStore<2, true>, pg8::StaticOrder, true, true>(lds, g, S, E);
        SEAM(8);
    }
    if (IN(9)) {
        pg8::Gemm g{(const pb*)(ws + WS_HMID), (const pb*)(ws + WS_W2), NT, DM, DFF}; pg8::StaticOrder S; S.init(NT, DM, G, (int)blockIdx.x);
        pg8::EpiRes<true, true> E{(const void*)(ws + WS_BUFA), p.out, nullptr, nullptr};
        pg8::gemm_phase<pg8::EpiRes<true, true>, pg8::StaticOrder, true, true>(lds, g, S, E);
    }
#ifdef PROBE_PH
    grid.sync(); STAMP(10);
    if (blockIdx.x == 0 && tid == 0) { const unsigned long long* ts = (const unsigned long long*)(ws + WS_CTL + 1024); p.out[0] = (float)(ts[PROBE_PH + 1] - ts[PROBE_PH]) * 0.01f; }
#endif
#ifdef DBG_DUMP
    if (hi == NPH + 1 || lo == NPH) {
        const bf16* src = (const bf16*)(ws + (size_t)DBG_DUMP);
        for (size_t i = (size_t)blockIdx.x * 512 + tid; i < (size_t)NT * DM; i += (size_t)G * 512) p.out[i] = __uint_as_float((unsigned)src[i] << 16);
    }
#endif
#undef IN
#undef SEAM
}

extern "C" void kernel_launch(void* const* d_in, const int* in_sizes, int n_in, void* d_out, int out_size, void* d_ws, size_t ws_size, hipStream_t stream) {
    static int grid = 0;
    if (grid == 0) {
        if (n_in != 23 || out_size != NT * DM || ws_size < WS_END) { fprintf(stderr, "kernel_launch: unexpected shapes (n_in %d out %d ws %zu)\n", n_in, out_size, ws_size); grid = -1; return; }
        int dev = 0, cus = 0, per_cu = 0;
        (void)hipGetDevice(&dev); (void)hipDeviceGetAttribute(&cus, hipDeviceAttributeMultiprocessorCount, dev);
        if (hipFuncSetAttribute((const void*)fwd, hipFuncAttributeMaxDynamicSharedMemorySize, LDS_BYTES) != hipSuccess) { fprintf(stderr, "kernel_launch: hipFuncSetAttribute failed\n"); grid = -1; return; }
        if (hipOccupancyMaxActiveBlocksPerMultiprocessor(&per_cu, (const void*)fwd, 512, LDS_BYTES) != hipSuccess || per_cu < 1) { fprintf(stderr, "kernel_launch: occupancy query says %d\n", per_cu); per_cu = 1; }
        (void)hipGetLastError();
        grid = cus * (per_cu < 1 ? 1 : 1);
        if (grid <= 0) grid = 256;
    }
    if (grid < 0) return;
    if (hipMemsetAsync((char*)d_ws + WS_CTL, 0, 65536, stream) != hipSuccess) { fprintf(stderr, "kernel_launch: hipMemsetAsync failed\n"); return; }
    Args a{};
    for (int i = 0; i < 23; ++i) a.p.in[i] = (const float*)d_in[i];
    a.p.out = (float*)d_out; a.p.ws = (unsigned char*)d_ws;
#if MK_MULTI
#ifdef DBG_DUMP
    for (int k = 0; k <= DBG_LAST; ++k) { a.ph_lo = k; a.ph_hi = k + 1; hipLaunchKernelGGL(fwd, dim3(grid), dim3(512), LDS_BYTES, stream, a); }
    a.ph_lo = NPH; a.ph_hi = NPH + 1; hipLaunchKernelGGL(fwd, dim3(grid), dim3(512), LDS_BYTES, stream, a);
#else
    for (int k = 0; k < NPH; ++k) { a.ph_lo = k; a.ph_hi = k + 1; hipLaunchKernelGGL(fwd, dim3(grid), dim3(512), LDS_BYTES, stream, a); }
#endif
#else
    a.ph_lo = 0; a.ph_hi = NPH;
    void* args[] = {&a};
    hipError_t e = hipLaunchCooperativeKernel((const void*)fwd, dim3(grid), dim3(512), args, LDS_BYTES, stream);
    if (e != hipSuccess) fprintf(stderr, "cooperative launch failed: %s (grid %d)\n", hipGetErrorString(e), grid);
#endif
}
```
